# Optimizing an MI355X kernel written in HIP

```python
import math
import jax, jax.numpy as jnp
from jax import lax
import numpy as np

D_MODEL = 1024
BATCH = 8
SEQ = 2048
DEPTH = 1

CHUNK = 64
D_MIX = D_MODEL
RET_WIDTH = D_MIX // 2
CONV_WIDTH = D_MIX - RET_WIDTH
RET_HEADS = 8
RET_HEAD_DIM = RET_WIDTH // RET_HEADS
CONV_GROUPS = 8
CONV_GROUP_DIM = CONV_WIDTH // CONV_GROUPS
CONV_K = 3
ROPE_BASE = 10000.0
N_GROUPS = 4
EXPERTS_PER_GROUP = 8
TOP_K = 2
D_EXPERT = D_MODEL // 2
EPS = 1e-6
GN_EPS = 1e-5
IN_COLS = 4 * RET_WIDTH + 3 * CONV_WIDTH

kernel_name = "hybrid_retention_shortconv_hmoe_adaln"


def rms_norm(x, g):
    xf = x.astype(jnp.float32)
    y = xf * lax.rsqrt(jnp.mean(xf * xf, axis=-1, keepdims=True) + EPS)
    return (y * g.astype(jnp.float32)).astype(x.dtype)


def rotary(positions, dim, dtype):
    inv_freq = ROPE_BASE ** (-jnp.arange(0, dim, 2, dtype=jnp.float32) / dim)
    ang = positions.astype(jnp.float32)[..., None] * inv_freq
    return jnp.cos(ang)[:, :, None, :].astype(dtype), jnp.sin(ang)[:, :, None, :].astype(dtype)


def apply_rotary(t, cos, sin):
    t1, t2 = jnp.split(t, 2, axis=-1)
    return jnp.concatenate([t1 * cos - t2 * sin, t2 * cos + t1 * sin], axis=-1)


def retention(q, k, v, positions):
    B, S, H, dh = q.shape
    nc = S // CHUNK
    dt = q.dtype
    cos, sin = rotary(positions, dh, dt)
    q = apply_rotary(q, cos, sin)
    k = apply_rotary(k, cos, sin) * (dh ** -0.5)

    def to_chunks(t):
        return t.reshape(B, nc, CHUNK, H, dh).transpose(0, 3, 1, 2, 4)

    qc, kc, vc = to_chunks(q), to_chunks(k), to_chunks(v)
    log_gamma = jnp.log1p(-jnp.exp2(-5.0 - jnp.arange(H, dtype=jnp.float32)))
    idx = jnp.arange(CHUNK, dtype=jnp.float32)
    dist = jnp.abs(idx[:, None] - idx[None, :])
    d_intra = jnp.exp(log_gamma[:, None, None] * dist).astype(dt)
    k_decay = jnp.exp(log_gamma[:, None] * (CHUNK - 1 - idx)).astype(dt)
    q_decay = jnp.exp(log_gamma[:, None] * (idx + 1.0)).astype(dt)
    chunk_decay = jnp.exp(log_gamma * CHUNK).astype(dt)

    scores = jnp.einsum('bhncd,bhnmd->bhncm', qc, kc) * d_intra[None, :, None]
    y_intra = jnp.einsum('bhncm,bhnmd->bhncd', scores, vc)

    kv = jnp.einsum('bhnmd,bhnme->bhnde', kc * k_decay[None, :, None, :, None], vc)

    def step(state, kv_i):
        return state * chunk_decay[None, :, None, None] + kv_i, state

    _, s_prev = lax.scan(step, jnp.zeros((B, H, dh, dh), kv.dtype), jnp.moveaxis(kv, 2, 0))
    s_prev = jnp.moveaxis(s_prev, 0, 2)
    y_inter = jnp.einsum('bhncd,bhnde->bhnce', qc * q_decay[None, :, None, :, None], s_prev)

    y = y_intra + y_inter
    return y.transpose(0, 2, 3, 1, 4).reshape(B, S, H, dh)


def group_norm_heads(y):
    yf = y.astype(jnp.float32)
    mu = jnp.mean(yf, axis=-1, keepdims=True)
    var = jnp.mean(jnp.square(yf - mu), axis=-1, keepdims=True)
    return ((yf - mu) * lax.rsqrt(var + GN_EPS)).astype(y.dtype)


def mixer(h, positions, w_in, conv_w, conv_b, beta_ret, beta_conv, w_out):
    B, S, _ = h.shape
    proj = h @ w_in
    q, k, v, g, b_gate, c_gate, h_conv = jnp.split(
        proj, np.cumsum([RET_WIDTH] * 4 + [CONV_WIDTH] * 2).tolist(), axis=-1)

    shp = (B, S, RET_HEADS, RET_HEAD_DIM)
    y_ret = retention(q.reshape(shp), k.reshape(shp), v.reshape(shp), positions)
    y_ret = group_norm_heads(y_ret).reshape(B, S, RET_WIDTH)
    y_ret = jax.nn.silu(g) * y_ret * beta_ret

    u = c_gate * h_conv
    conv = lax.conv_general_dilated(
        u, conv_w[:, None, :], window_strides=(1,), padding=[(CONV_K - 1, 0)],
        dimension_numbers=('NWC', 'WIO', 'NWC'), feature_group_count=CONV_WIDTH) + conv_b
    y_conv = (b_gate * conv).reshape(B, S, CONV_GROUPS, CONV_GROUP_DIM)
    y_conv = rms_norm(y_conv, jnp.ones((CONV_GROUP_DIM,), y_conv.dtype)).reshape(B, S, CONV_WIDTH)
    y_conv = y_conv * beta_conv

    return jnp.concatenate([y_ret, y_conv], axis=-1) @ w_out


def hier_moe(h, wg, bg, we, be, w_gate, w_up, w_down):
    B, S, D = h.shape
    t = h.reshape(-1, D)
    n = t.shape[0]
    g_prob = jax.nn.softmax((t @ wg + bg).astype(jnp.float32), axis=-1)
    g_top, g_idx = lax.top_k(g_prob, 1)
    e_logits = (t @ we + be).astype(jnp.float32).reshape(n, N_GROUPS, EXPERTS_PER_GROUP)
    e_sel = jnp.take_along_axis(e_logits, g_idx[:, :, None], axis=1)[:, 0]
    e_prob = jax.nn.softmax(e_sel, axis=-1)
    e_top, e_idx = lax.top_k(e_prob, TOP_K)
    e_w = e_top / jnp.sum(e_top, axis=-1, keepdims=True) * g_top
    within = jnp.sum(jax.nn.one_hot(e_idx, EXPERTS_PER_GROUP, dtype=jnp.float32) * e_w[..., None], axis=1)
    combine = (jax.nn.one_hot(g_idx[:, 0], N_GROUPS, dtype=jnp.float32)[:, :, None]
               * within[:, None, :]).astype(t.dtype)
    out = jnp.zeros_like(t)
    for gi in range(N_GROUPS):
        a = jnp.einsum('nd,edf->nef', t, w_gate[gi])
        u = jnp.einsum('nd,edf->nef', t, w_up[gi])
        hid = jax.nn.silu(a) * u * combine[:, gi, :, None]
        out = out + jnp.einsum('nef,efd->nd', hid, w_down[gi])
    return out.reshape(B, S, D)


def setup_inputs(seed: int = 0) -> dict:
    key = jax.random.key(seed)
    ks = jax.random.split(key, 24)
    f32 = jnp.float32
    nrm = lambda k, shape, s: jax.random.normal(k, shape, f32) * s
    x = jax.random.normal(ks[0], (BATCH, SEQ, D_MODEL), f32)
    c = jax.random.normal(ks[1], (BATCH, D_MODEL), f32)
    offset = jax.random.randint(ks[2], (BATCH, 1), 0, 4096, dtype=jnp.int32)
    positions = (offset + jnp.arange(SEQ, dtype=jnp.int32)[None, :]).astype(jnp.int32)
    ge = N_GROUPS * EXPERTS_PER_GROUP
    return {
        "x": x,
        "c": c,
        "positions": positions,
        "ada_w": nrm(ks[3], (DEPTH, D_MODEL, 6 * D_MODEL), 0.5 * D_MODEL ** -0.5),
        "ada_b": nrm(ks[4], (DEPTH, 6 * D_MODEL), 0.02),
        "norm_mix_g": 1.0 + nrm(ks[5], (DEPTH, D_MODEL), 0.02),
        "norm_ffn_g": 1.0 + nrm(ks[6], (DEPTH, D_MODEL), 0.02),
        "w_in": nrm(ks[7], (DEPTH, D_MODEL, IN_COLS), D_MODEL ** -0.5),
        "conv_w": nrm(ks[8], (DEPTH, CONV_K, CONV_WIDTH), CONV_K ** -0.5),
        "conv_b": nrm(ks[9], (DEPTH, CONV_WIDTH), 0.02),
        "beta_ret": 1.0 + nrm(ks[10], (DEPTH, RET_WIDTH), 0.02),
        "beta_conv": 1.0 + nrm(ks[11], (DEPTH, CONV_WIDTH), 0.02),
        "w_out": nrm(ks[12], (DEPTH, D_MIX, D_MODEL), D_MIX ** -0.5),
        "router_group_w": nrm(ks[13], (DEPTH, D_MODEL, N_GROUPS), D_MODEL ** -0.5),
        "router_group_b": nrm(ks[14], (DEPTH, N_GROUPS), 0.01),
        "router_expert_w": nrm(ks[15], (DEPTH, D_MODEL, ge), D_MODEL ** -0.5),
        "router_expert_b": nrm(ks[16], (DEPTH, ge), 0.01),
        "expert_w_gate": nrm(ks[17], (DEPTH, N_GROUPS, EXPERTS_PER_GROUP, D_MODEL, D_EXPERT), D_MODEL ** -0.5),
        "expert_w_up": nrm(ks[18], (DEPTH, N_GROUPS, EXPERTS_PER_GROUP, D_MODEL, D_EXPERT), D_MODEL ** -0.5),
        "expert_w_down": nrm(ks[19], (DEPTH, N_GROUPS, EXPERTS_PER_GROUP, D_EXPERT, D_MODEL), D_EXPERT ** -0.5),
        "norm_final_g": 1.0 + nrm(ks[20], (D_MODEL,), 0.02),
    }


def reference(x, c, positions, ada_w, ada_b, norm_mix_g, norm_ffn_g, w_in, conv_w, conv_b,
              beta_ret, beta_conv, w_out, router_group_w, router_group_b, router_expert_w,
              router_expert_b, expert_w_gate, expert_w_up, expert_w_down, norm_final_g):
    for l in range(DEPTH):
        mod = jax.nn.silu(c) @ ada_w[l] + ada_b[l]
        shift_m, scale_m, gate_m, shift_f, scale_f, gate_f = jnp.split(mod[:, None, :], 6, axis=-1)

        h = rms_norm(x, norm_mix_g[l]) * (1.0 + scale_m) + shift_m
        x = x + gate_m * mixer(h, positions, w_in[l], conv_w[l], conv_b[l],
                               beta_ret[l], beta_conv[l], w_out[l])

        h = rms_norm(x, norm_ffn_g[l]) * (1.0 + scale_f) + shift_f
        x = x + gate_f * hier_moe(h, router_group_w[l], router_group_b[l], router_expert_w[l],
                                  router_expert_b[l], expert_w_gate[l], expert_w_up[l],
                                  expert_w_down[l])
    return rms_norm(x, norm_final_g)
```

```cpp
#include <hip/hip_runtime.h>
#include <stdint.h>
#include <string.h>

#ifndef MK_LAUNCHES
#define MK_LAUNCHES 1
#endif

#define LAS __attribute__((address_space(3)))
typedef unsigned short bf16_t;
typedef short bf16x8 __attribute__((ext_vector_type(8)));
typedef short s16x4 __attribute__((ext_vector_type(4)));
typedef float f32x4 __attribute__((ext_vector_type(4)));
typedef unsigned u32x4 __attribute__((ext_vector_type(4)));
typedef unsigned u32x2 __attribute__((ext_vector_type(2)));

constexpr int DM = 1024, NB = 8, SEQ = 2048, NTOK = NB * SEQ, INC = 3584, NH = 8, NE = 32, DE = 512, MODW = 6144, LCAP = 16384;
constexpr int NWG = 256, NTHR = 512;
constexpr int NGEMM = 224;
#ifndef W1_PRE
#define W1_PRE 4096
#endif
constexpr int LDS_BYTES = 147456;
constexpr int LDS_MISC = 146432;

#define XB_TMO      128
#define XB_XCNT(j)  (256  + 64 * (j))
#define XB_XSUB(j)  (1280 + 64 * (j))
#define XB_XGEN(j)  (2304 + 64 * (j))
#define XB_TOP      3328
#define XB_TOPGEN   3392
#define XCD_BAR_WORDS 3456
#define XB_SPIN_CAP (1u << 18)
__device__ __forceinline__ unsigned xb_ld(unsigned* p)              { return __hip_atomic_load(p, __ATOMIC_RELAXED, __HIP_MEMORY_SCOPE_AGENT); }
__device__ __forceinline__ unsigned xb_add(unsigned* p, unsigned v) { return __hip_atomic_fetch_add(p, v, __ATOMIC_RELAXED, __HIP_MEMORY_SCOPE_AGENT); }
__device__ __forceinline__ unsigned xb_xcc_id() { return (unsigned)__builtin_amdgcn_s_getreg((3 << 11) | 20) & 0xFu; }
#define XB_SPIN(cond, bar) do { unsigned _sp = 0; while (cond) { __builtin_amdgcn_s_sleep(1); \
    if ((++_sp & 255u) == 0u) { if (xb_ld(&(bar)[XB_TMO])) break; if (_sp > XB_SPIN_CAP) { atomicAdd(&(bar)[XB_TMO], 1u); break; } } } } while (0)
struct XcdBarrier { unsigned* bar; unsigned x; volatile LAS unsigned* st; };
__device__ __forceinline__ XcdBarrier xcd_barrier_post(unsigned* bar, volatile LAS unsigned* st) {
    XcdBarrier b; b.bar = bar; b.x = xb_xcc_id(); b.st = st;
    if (threadIdx.x == 0) (void)xb_add(&bar[XB_XCNT(b.x)], 1u);
    return b;
}
__device__ __forceinline__ void xcd_barrier_complete(unsigned* bar, unsigned x, unsigned& nloc, unsigned& nx) {
    const unsigned G = gridDim.x * gridDim.y * gridDim.z;
    unsigned sum, cnt, mine, sp = 0u;
    for (;;) {
        sum = 0u; cnt = 0u; mine = 0u;
#pragma unroll
        for (unsigned j = 0; j < 16; ++j) { const unsigned c = xb_ld(&bar[XB_XCNT(j)]); sum += c; cnt += (c > 0u) ? 1u : 0u; mine = (j == x) ? c : mine; }
        if (sum == G) break;
        __builtin_amdgcn_s_sleep(1);
        if ((++sp & 255u) == 0u) { if (xb_ld(&bar[XB_TMO])) break; if (sp > XB_SPIN_CAP) { atomicAdd(&bar[XB_TMO], 1u); break; } }
    }
    nloc = mine > 0u ? mine : 1u; nx = cnt > 0u ? cnt : 1u;
}
__device__ __forceinline__ void xcd_barrier(const XcdBarrier& b) {
    asm volatile("s_waitcnt vmcnt(0)" ::: "memory");
    __syncthreads();
    if (threadIdx.x == 0) {
        unsigned* bar = b.bar;
        __builtin_amdgcn_s_waitcnt(0);
        unsigned nloc = b.st[0], nx = b.st[1];
        if (nloc == 0u) { xcd_barrier_complete(bar, b.x, nloc, nx); b.st[0] = nloc; b.st[1] = nx; }
        const unsigned old = xb_add(&bar[XB_XSUB(b.x)], 1u);
        const unsigned gen = old / nloc;
        if (old + 1u == (gen + 1u) * nloc) {
            __builtin_amdgcn_fence(__ATOMIC_RELEASE, "agent");
            asm volatile("s_waitcnt vmcnt(0)" ::: "memory");
            const unsigned og = xb_add(&bar[XB_TOP], 1u);
            const unsigned tg = og / nx;
            if (og + 1u == (tg + 1u) * nx) xb_add(&bar[XB_TOPGEN], 1u);
            else XB_SPIN(xb_ld(&bar[XB_TOPGEN]) == tg, bar);
            __builtin_amdgcn_fence(__ATOMIC_ACQUIRE, "agent");
            xb_add(&bar[XB_XGEN(b.x)], 1u);
            asm volatile("s_waitcnt vmcnt(0)" ::: "memory");
        } else {
            XB_SPIN(xb_ld(&bar[XB_XGEN(b.x)]) == gen, bar);
            __builtin_amdgcn_fence(__ATOMIC_ACQUIRE, "agent");
            asm volatile("s_waitcnt vmcnt(0)" ::: "memory");
        }
    }
    __syncthreads();
}

typedef __bf16 bf16x2_t __attribute__((ext_vector_type(2)));
typedef float f32x2_t __attribute__((ext_vector_type(2)));
__device__ __forceinline__ unsigned cvt_pk_bf16(float lo, float hi) { const f32x2_t f = {lo, hi}; return __builtin_bit_cast(unsigned, __builtin_convertvector(f, bf16x2_t)); }
__device__ __forceinline__ float bf_lo(unsigned w) { return __uint_as_float(w << 16); }
__device__ __forceinline__ float bf_hi(unsigned w) { return __uint_as_float(w & 0xffff0000u); }
__device__ __forceinline__ float fast_silu(float x) { return x * __builtin_amdgcn_rcpf(1.f + __builtin_amdgcn_exp2f(-1.44269504089f * x)); }
__device__ __forceinline__ float wave_sum(float v) {
#pragma unroll
    for (int o = 32; o >= 1; o >>= 1) v += __shfl_xor(v, o);
    return v;
}

struct Args {
    const float *x, *c; const int* pos;
    const float *ada_w, *ada_b, *g_mix, *g_ffn, *w_in, *conv_w, *conv_b, *beta_ret, *beta_conv, *w_out, *rgw, *rgb, *rew, *reb, *ewg, *ewu, *ewd, *g_fin;
    float* out;
    unsigned* bar; int* counts; unsigned* segflag; float* mod; int* lists; float* pw; float* sseg;
    bf16_t *WinT, *WoutT, *W1T, *W2T, *WrT;
    bf16_t *h, *Qp, *Kp, *Vp, *Gp, *Bp, *Up, *Y, *h2, *hid, *opair, *x1b;
    int p0, p1;
};

namespace pg8 {
constexpr int BM = 256, BK = 64, HALF = 128, HTB = HALF * BK * 2, STAGE_BYTES = 8 * HTB;
__device__ __forceinline__ int lds_byte(int r, int c) { const int st = (r >> 4) * 2 + (c >> 5), rr = r & 15, cc = c & 31, ob = rr * 64 + cc * 2; return st * 1024 + (ob ^ (((ob >> 9) & 1) << 5)); }
__device__ __forceinline__ void stage_rc(int b, int& R, int& C) { const int st = b / 1024, sb = b % 1024, swz = sb ^ (((sb >> 9) & 1) << 5); R = (st >> 1) * 16 + swz / 64; C = (st & 1) * 32 + (swz % 64) / 2; }
__device__ __forceinline__ int perm32(int rho) { const int n = rho >> 4, i = rho & 15; return 8 * (i >> 2) + 4 * n + (i & 3); }

struct Unit { int pm, pn, e, cnt; };

template <class P>
__device__ __forceinline__ void gemm_phase(LAS unsigned char* lds, const P& prob) {
    const int tid = threadIdx.x, wid = __builtin_amdgcn_readfirstlane(tid >> 6), lane = tid & 63, wr = wid >> 2, wc = wid & 3, fr = lane & 15, fq = lane >> 4;
    const int K = prob.K, nt = K / BK;
    int RA[2]; unsigned CA2[2], voffB[2];
#pragma unroll
    for (int i = 0; i < 2; ++i) { int R, C; stage_rc(tid * 16 + i * 8192, R, C); const int Rb = P::PERM ? ((R & ~31) + perm32(R & 31)) : R;
        RA[i] = R; CA2[i] = (unsigned)C * 2u; voffB[i] = (unsigned)(Rb * K + C) * 2u; }
    const unsigned kstep = (unsigned)(BK * 2);
    const size_t hstep = (size_t)HALF * K * 2;
    const unsigned ldsw = (unsigned)wid * 1024u;
    const int aoff = lds_byte(wr * 64 + fr, fq * 8), boff = lds_byte(wc * 32 + fr, fq * 8);
#define PG8_SA(b, h) (((b) * 2 + (h)) * HTB)
#define PG8_SB(b, h) ((4 + (b) * 2 + (h)) * HTB)
#define PG8_STAGE_B(bufoff, gbase) do { _Pragma("unroll") for (int _i = 0; _i < 2; ++_i) \
        __builtin_amdgcn_global_load_lds((const unsigned*)((const char*)(gbase) + voffB[_i]), (LAS unsigned*)(lds + (bufoff) + ldsw + _i * 8192), 16, 0, 0); } while (0)
#define PG8_STAGE_A(bufoff, offh, kb) do { _Pragma("unroll") for (int _i = 0; _i < 2; ++_i) \
        __builtin_amdgcn_global_load_lds((const unsigned*)(Ab + (size_t)((offh)[_i] + (kb))), (LAS unsigned*)(lds + (bufoff) + ldsw + _i * 8192), 16, 0, 0); } while (0)
#define PG8_LDA(dst, b, h) do { _Pragma("unroll") for (int m = 0; m < 4; ++m) _Pragma("unroll") for (int k = 0; k < 2; ++k) dst[m][k] = *(const LAS bf16x8*)(lds + PG8_SA(b, h) + aoff + m * 2048 + k * 1024); } while (0)
#define PG8_LDB(dst, b, h) do { _Pragma("unroll") for (int n = 0; n < 2; ++n) _Pragma("unroll") for (int k = 0; k < 2; ++k) dst[n][k] = *(const LAS bf16x8*)(lds + PG8_SB(b, h) + boff + n * 2048 + k * 1024); } while (0)
#define PG8_MMA(ai, bj, At, Bt) do { __builtin_amdgcn_s_setprio(1); _Pragma("unroll") for (int m = 0; m < 4; ++m) _Pragma("unroll") for (int n = 0; n < 2; ++n) _Pragma("unroll") for (int k = 0; k < 2; ++k) \
        acc[ai][bj][m][n] = __builtin_amdgcn_mfma_f32_16x16x32_bf16(Bt[n][k], At[m][k], acc[ai][bj][m][n], 0, 0, 0); __builtin_amdgcn_s_setprio(0); } while (0)
#define PG8_WAIT_V(n) asm volatile("s_waitcnt vmcnt(" #n ")" ::: "memory")
#define PG8_WAIT_L(n) asm volatile("s_waitcnt lgkmcnt(" #n ")" ::: "memory")
#define PG8_BAR __builtin_amdgcn_s_barrier()
#define PG8_SCHED __builtin_amdgcn_sched_barrier(0)
    Unit cur, nxt; int ui = 0;
    if (!prob.next(0, cur)) return;
    f32x4 acc[2][2][4][2];
#pragma unroll
    for (int a = 0; a < 2; ++a)
#pragma unroll
        for (int b = 0; b < 2; ++b)
#pragma unroll
            for (int m = 0; m < 4; ++m)
#pragma unroll
                for (int n = 0; n < 2; ++n) acc[a][b][m][n] = (f32x4){0.f, 0.f, 0.f, 0.f};
    bf16x8 At[4][2], B0[2][2], B1[2][2];
    const char* Ab = prob.a_base();
    unsigned cO0[2], cO1[2], nO0[2], nO1[2];
#pragma unroll
    for (int i = 0; i < 2; ++i) { cO0[i] = prob.a_row(cur, RA[i]) + CA2[i]; cO1[i] = prob.a_row(cur, HALF + RA[i]) + CA2[i]; }
    const char* cB = prob.b_tile(cur);
    PG8_STAGE_B(PG8_SB(0, 0), cB); PG8_STAGE_A(PG8_SA(0, 0), cO0, 0u); PG8_STAGE_B(PG8_SB(0, 1), cB + hstep); PG8_STAGE_A(PG8_SA(0, 1), cO1, 0u);
    if (wr == 1) PG8_BAR;
    PG8_WAIT_V(4); PG8_BAR;
    PG8_STAGE_B(PG8_SB(1, 0), cB + kstep); PG8_STAGE_A(PG8_SA(1, 0), cO0, kstep); PG8_STAGE_B(PG8_SB(1, 1), cB + hstep + kstep);
    PG8_WAIT_V(6); PG8_BAR;
    for (;;) {
        const bool has_next = prob.next(ui + 1, nxt);
        const char* nB = cB;
#pragma unroll
        for (int i = 0; i < 2; ++i) { nO0[i] = cO0[i]; nO1[i] = cO1[i]; }
        if (has_next) {
            nB = prob.b_tile(nxt);
#pragma unroll
            for (int i = 0; i < 2; ++i) { nO0[i] = prob.a_row(nxt, RA[i]) + CA2[i]; nO1[i] = prob.a_row(nxt, HALF + RA[i]) + CA2[i]; }
        }
        for (int t = 0; t < nt; t += 2) {
            const bool last = (t == nt - 2);
            const unsigned k1 = (unsigned)(t + 1) * kstep;
            const unsigned k2 = last ? 0u : (unsigned)(t + 2) * kstep, k3 = k2 + kstep;
            unsigned o20[2], o21[2];
#pragma unroll
            for (int i = 0; i < 2; ++i) { o20[i] = last ? nO0[i] : cO0[i]; o21[i] = last ? nO1[i] : cO1[i]; }
            const char* b2 = last ? nB : cB + (size_t)(t + 2) * kstep; const char* b3 = b2 + kstep;
            PG8_LDB(B0, 0, 0); PG8_SCHED; PG8_LDA(At, 0, 0); PG8_STAGE_A(PG8_SA(1, 1), cO1, k1);
            PG8_WAIT_L(8); PG8_BAR; PG8_WAIT_L(0); PG8_MMA(0, 0, At, B0); PG8_BAR; PG8_SCHED;
            PG8_LDB(B1, 0, 1); PG8_STAGE_B(PG8_SB(0, 0), b2);
            PG8_BAR; PG8_WAIT_L(0); PG8_MMA(0, 1, At, B1); PG8_BAR;
            PG8_LDA(At, 0, 1); PG8_STAGE_A(PG8_SA(0, 0), o20, k2);
            PG8_BAR; PG8_WAIT_L(0); PG8_MMA(1, 0, At, B0); PG8_BAR; PG8_SCHED;
            PG8_STAGE_B(PG8_SB(0, 1), b2 + hstep);
            PG8_WAIT_V(6); PG8_BAR; PG8_MMA(1, 1, At, B1); PG8_BAR;
            PG8_LDB(B0, 1, 0); PG8_SCHED; PG8_LDA(At, 1, 0); PG8_STAGE_A(PG8_SA(0, 1), o21, k2);
            PG8_WAIT_L(8); PG8_BAR; PG8_WAIT_L(0); PG8_MMA(0, 0, At, B0); PG8_BAR; PG8_SCHED;
            PG8_LDB(B1, 1, 1); PG8_STAGE_B(PG8_SB(1, 0), b3);
            PG8_BAR; PG8_WAIT_L(0); PG8_MMA(0, 1, At, B1); PG8_BAR;
            PG8_LDA(At, 1, 1); PG8_STAGE_A(PG8_SA(1, 0), o20, k3);
            PG8_BAR; PG8_WAIT_L(0); PG8_MMA(1, 0, At, B0); PG8_BAR; PG8_SCHED;
            PG8_STAGE_B(PG8_SB(1, 1), b3 + hstep);
            PG8_WAIT_V(6); PG8_BAR; PG8_MMA(1, 1, At, B1); PG8_BAR;
        }
        prob.epi(acc, cur, wr, wc, fr, fq);
        if (!has_next) break;
#pragma unroll
        for (int a = 0; a < 2; ++a)
#pragma unroll
            for (int b = 0; b < 2; ++b)
#pragma unroll
                for (int m = 0; m < 4; ++m)
#pragma unroll
                    for (int n = 0; n < 2; ++n) acc[a][b][m][n] = (f32x4){0.f, 0.f, 0.f, 0.f};
        cur = nxt; cB = nB; ++ui;
#pragma unroll
        for (int i = 0; i < 2; ++i) { cO0[i] = nO0[i]; cO1[i] = nO1[i]; }
    }
    PG8_WAIT_V(0);
    if (wr == 0) PG8_BAR;
    PG8_BAR;
#undef PG8_SA
#undef PG8_SB
#undef PG8_STAGE_A
#undef PG8_STAGE_B
#undef PG8_LDA
#undef PG8_LDB
#undef PG8_MMA
#undef PG8_WAIT_V
#undef PG8_WAIT_L
#undef PG8_BAR
#undef PG8_SCHED
}

struct StaticOrder {
    int nM, nN, nwg, G, c;
    __device__ void init(int M, int N, int G_, int c_) { nM = M / BM; nN = N / BM; nwg = nM * nN; G = G_; c = c_; }
    __device__ bool next(int i, Unit& u) const {
        const long L = (long)i * G + c; if (L >= nwg) return false;
        int wgid = (int)L; { const int q = nwg / 8, r = nwg % 8, xcd = wgid % 8, off = wgid / 8; wgid = (xcd < r ? xcd * (q + 1) : r * (q + 1) + (xcd - r) * q) + off; }
        const int nig = 8 * nN, gid = wgid / nig, fm = gid * 8, gsz = (nM - fm) < 8 ? (nM - fm) : 8;
        u.pm = fm + ((wgid % nig) % gsz); u.pn = (wgid % nig) / gsz; u.e = 0; u.cnt = 256; return true;
    }
};
}
using pg8::Unit;
typedef f32x4 AccT[2][2][4][2];

struct ProbInProj {
    static constexpr bool PERM = true;
    int K; pg8::StaticOrder S; const char* A; const char* Bt; const int* pos; bf16_t *Qp, *Kp, *Vp, *Gp, *Bp, *Up;
    __device__ __forceinline__ bool next(int i, Unit& u) const { return S.next(i, u); }
    __device__ __forceinline__ const char* a_base() const { return A; }
    __device__ __forceinline__ unsigned a_row(const Unit& u, int r) const { return (unsigned)(u.pm * 256 + r) * (unsigned)(DM * 2); }
    __device__ __forceinline__ const char* b_tile(const Unit& u) const { return Bt + (size_t)u.pn * 256 * DM * 2; }
    __device__ __forceinline__ void epi(const AccT& acc, const Unit& u, int wr, int wc, int fr, int fq) const {
        const int row0 = u.pm * 256 + wr * 64 + fr, pn = u.pn;
        if (pn < 4) {
            bf16_t* dst = Qp + (size_t)(pn >> 1) * ((size_t)NTOK * 512); const float sc = pn >= 2 ? 0.125f : 1.0f; const int head = 4 * (pn & 1) + wc;
            float invf[8];
#pragma unroll
            for (int q = 0; q < 8; ++q) invf[q] = __builtin_amdgcn_exp2f(-(float)(8 * fq + q) * (13.287712379549449f / 32.f)) * 0.15915494309189535f;
#pragma unroll
            for (int ai = 0; ai < 2; ++ai)
#pragma unroll
                for (int m = 0; m < 4; ++m) {
                    const int tok = row0 + ai * 128 + m * 16; const float p = (float)pos[tok];
                    float o1[8], o2[8];
#pragma unroll
                    for (int n = 0; n < 2; ++n)
#pragma unroll
                        for (int j = 0; j < 4; ++j) {
                            float rev = p * invf[4 * n + j]; rev = rev - __builtin_floorf(rev);
                            const float sn = __builtin_amdgcn_sinf(rev), cs = __builtin_amdgcn_cosf(rev);
                            const float t1 = acc[ai][0][m][n][j], t2 = acc[ai][1][m][n][j];
                            o1[4 * n + j] = (t1 * cs - t2 * sn) * sc; o2[4 * n + j] = (t2 * cs + t1 * sn) * sc;
                        }
                    bf16_t* rp = dst + (size_t)tok * 512 + head * 64 + 8 * fq;
                    u32x4 w1, w2;
                    w1.x = cvt_pk_bf16(o1[0], o1[1]); w1.y = cvt_pk_bf16(o1[2], o1[3]); w1.z = cvt_pk_bf16(o1[4], o1[5]); w1.w = cvt_pk_bf16(o1[6], o1[7]);
                    w2.x = cvt_pk_bf16(o2[0], o2[1]); w2.y = cvt_pk_bf16(o2[2], o2[3]); w2.z = cvt_pk_bf16(o2[4], o2[5]); w2.w = cvt_pk_bf16(o2[6], o2[7]);
                    *(u32x4*)rp = w1; *(u32x4*)(rp + 32) = w2;
                }
        } else if (pn < 10) {
            const int grp = (pn - 4) >> 1; bf16_t* dst = Vp + (size_t)grp * ((size_t)NTOK * 512); const bool act = grp == 1;
            const int col0 = (pn & 1) * 256 + wc * 32 + 8 * fq;
#pragma unroll
            for (int ai = 0; ai < 2; ++ai)
#pragma unroll
                for (int m = 0; m < 4; ++m) {
                    bf16_t* rp = dst + (size_t)(row0 + ai * 128 + m * 16) * 512 + col0;
#pragma unroll
                    for (int bj = 0; bj < 2; ++bj) {
                        f32x4 v0 = acc[ai][bj][m][0], v1 = acc[ai][bj][m][1];
                        if (act) {
#pragma unroll
                            for (int j = 0; j < 4; ++j) { v0[j] = fast_silu(v0[j]); v1[j] = fast_silu(v1[j]); }
                        }
                        u32x4 w; w.x = cvt_pk_bf16(v0[0], v0[1]); w.y = cvt_pk_bf16(v0[2], v0[3]); w.z = cvt_pk_bf16(v1[0], v1[1]); w.w = cvt_pk_bf16(v1[2], v1[3]);
                        *(u32x4*)(rp + bj * 128) = w;
                    }
                }
        } else {
            const int ch0 = 128 * (pn - 10) + wc * 32 + 8 * fq;
#pragma unroll
            for (int ai = 0; ai < 2; ++ai)
#pragma unroll
                for (int m = 0; m < 4; ++m) {
                    const f32x4 v0 = acc[ai][0][m][0] * acc[ai][1][m][0], v1 = acc[ai][0][m][1] * acc[ai][1][m][1];
                    u32x4 w; w.x = cvt_pk_bf16(v0[0], v0[1]); w.y = cvt_pk_bf16(v0[2], v0[3]); w.z = cvt_pk_bf16(v1[0], v1[1]); w.w = cvt_pk_bf16(v1[2], v1[3]);
                    *(u32x4*)(Up + (size_t)(row0 + ai * 128 + m * 16) * 512 + ch0) = w;
                }
        }
    }
};

struct ProbOutProj {
    static constexpr bool PERM = true;
    int K; pg8::StaticOrder S; const char* A; const char* Bt; const float* x; const float* mod; bf16_t* x1;
    __device__ __forceinline__ bool next(int i, Unit& u) const { return S.next(i, u); }
    __device__ __forceinline__ const char* a_base() const { return A; }
    __device__ __forceinline__ unsigned a_row(const Unit& u, int r) const { return (unsigned)(u.pm * 256 + r) * (unsigned)(DM * 2); }
    __device__ __forceinline__ const char* b_tile(const Unit& u) const { return Bt + (size_t)u.pn * 256 * DM * 2; }
    __device__ __forceinline__ void epi(const AccT& acc, const Unit& u, int wr, int wc, int fr, int fq) const {
        const int row0 = u.pm * 256 + wr * 64 + fr, col0 = u.pn * 256 + wc * 32 + 8 * fq;
        const float* gate = mod + (size_t)(u.pm >> 3) * MODW + 2 * DM;
        f32x4 gv[2][2];
#pragma unroll
        for (int bj = 0; bj < 2; ++bj)
#pragma unroll
            for (int n = 0; n < 2; ++n) gv[bj][n] = *(const f32x4*)(gate + col0 + bj * 128 + n * 4);
#pragma unroll
        for (int ai = 0; ai < 2; ++ai)
#pragma unroll
            for (int m = 0; m < 4; ++m) {
                const size_t off = (size_t)(row0 + ai * 128 + m * 16) * DM + col0;
#pragma unroll
                for (int bj = 0; bj < 2; ++bj) {
                    const f32x4 x0 = *(const f32x4*)(x + off + bj * 128), x1v = *(const f32x4*)(x + off + bj * 128 + 4);
                    const f32x4 v0 = x0 + gv[bj][0] * acc[ai][bj][m][0], v1 = x1v + gv[bj][1] * acc[ai][bj][m][1];
                    u32x4 w; w.x = cvt_pk_bf16(v0[0], v0[1]); w.y = cvt_pk_bf16(v0[2], v0[3]); w.z = cvt_pk_bf16(v1[0], v1[1]); w.w = cvt_pk_bf16(v1[2], v1[3]);
                    *(u32x4*)(x1 + off + bj * 128) = w;
                }
            }
    }
};

struct MoeOrder {
    const LAS int* pre;
    const LAS int* cnts;
    int G, c, NT;
    __device__ __forceinline__ bool next(int i, Unit& u) const {
        int L = i * G + c;
        const int total = __builtin_amdgcn_readfirstlane(pre[32]);
        if (L >= total) return false;
        { const int q = total >> 3, r = total & 7, xcd = L & 7, off = L >> 3; L = (xcd < r ? xcd * (q + 1) : r * (q + 1) + (xcd - r) * q) + off; }
        int e = 0;
        for (int j = 1; j < 32; ++j) e += (__builtin_amdgcn_readfirstlane(pre[j]) <= L) ? 1 : 0;
        const int cnt = __builtin_amdgcn_readfirstlane(cnts[e]), tiles = (cnt + 255) >> 8, local = L - __builtin_amdgcn_readfirstlane(pre[e]);
        u.e = e; u.cnt = cnt; u.pn = local / tiles; u.pm = local - u.pn * tiles; return true;
    }
};
struct ProbMoe1 {
    static constexpr bool PERM = true;
    int K; MoeOrder S; const char* A; const char* Bt; const int* lists; const float* pw; bf16_t* hid;
    __device__ __forceinline__ bool next(int i, Unit& u) const { return S.next(i, u); }
    __device__ __forceinline__ const char* a_base() const { return A; }
    __device__ __forceinline__ unsigned a_row(const Unit& u, int r) const { int s = u.pm * 256 + r; s = s < u.cnt ? s : u.cnt - 1; const int p = lists[u.e * LCAP + s]; return (unsigned)(p >> 1) * (unsigned)(DM * 2); }
    __device__ __forceinline__ const char* b_tile(const Unit& u) const { return Bt + ((size_t)u.e * 4 + u.pn) * 256 * DM * 2; }
    __device__ __forceinline__ void epi(const AccT& acc, const Unit& u, int wr, int wc, int fr, int fq) const {
        const int col0 = u.pn * 128 + wc * 32 + 8 * fq;
#pragma unroll
        for (int ai = 0; ai < 2; ++ai)
#pragma unroll
            for (int m = 0; m < 4; ++m) {
                const int s = u.pm * 256 + ai * 128 + wr * 64 + m * 16 + fr;
                if (s < u.cnt) {
                    const int p = lists[u.e * LCAP + s]; const float w = pw[p];
                    const f32x4 a0 = acc[ai][0][m][0], a1 = acc[ai][0][m][1], u0 = acc[ai][1][m][0], u1 = acc[ai][1][m][1];
                    float o[8];
#pragma unroll
                    for (int j = 0; j < 4; ++j) { o[j] = fast_silu(a0[j]) * u0[j] * w; o[4 + j] = fast_silu(a1[j]) * u1[j] * w; }
                    u32x4 wv; wv.x = cvt_pk_bf16(o[0], o[1]); wv.y = cvt_pk_bf16(o[2], o[3]); wv.z = cvt_pk_bf16(o[4], o[5]); wv.w = cvt_pk_bf16(o[6], o[7]);
                    *(u32x4*)(hid + (size_t)p * DE + col0) = wv;
                }
            }
    }
};
struct ProbMoe2 {
    static constexpr bool PERM = true;
    int K; MoeOrder S; const char* A; const char* Bt; const int* lists; bf16_t* opair;
    __device__ __forceinline__ bool next(int i, Unit& u) const { return S.next(i, u); }
    __device__ __forceinline__ const char* a_base() const { return A; }
    __device__ __forceinline__ unsigned a_row(const Unit& u, int r) const { int s = u.pm * 256 + r; s = s < u.cnt ? s : u.cnt - 1; const int p = lists[u.e * LCAP + s]; return (unsigned)p * (unsigned)(DE * 2); }
    __device__ __forceinline__ const char* b_tile(const Unit& u) const { return Bt + ((size_t)u.e * 4 + u.pn) * 256 * DE * 2; }
    __device__ __forceinline__ void epi(const AccT& acc, const Unit& u, int wr, int wc, int fr, int fq) const {
        const int col0 = u.pn * 256 + wc * 32 + 8 * fq;
#pragma unroll
        for (int ai = 0; ai < 2; ++ai)
#pragma unroll
            for (int m = 0; m < 4; ++m) {
                const int s = u.pm * 256 + ai * 128 + wr * 64 + m * 16 + fr;
                if (s < u.cnt) {
                    const int p = lists[u.e * LCAP + s];
                    bf16_t* rp = opair + (size_t)p * DM + col0;
#pragma unroll
                    for (int bj = 0; bj < 2; ++bj) {
                        const f32x4 v0 = acc[ai][bj][m][0], v1 = acc[ai][bj][m][1];
                        u32x4 w; w.x = cvt_pk_bf16(v0[0], v0[1]); w.y = cvt_pk_bf16(v0[2], v0[3]); w.z = cvt_pk_bf16(v1[0], v1[1]); w.w = cvt_pk_bf16(v1[2], v1[3]);
                        *(u32x4*)(rp + bj * 128) = w;
                    }
                }
            }
    }
};
__device__ __forceinline__ void moe_tables(const int* counts, LAS int* pre, LAS int* cnts) {
    if (threadIdx.x < 64) {
        const int l = threadIdx.x; const int cnt = l < 32 ? counts[l] : 0; const int un = ((cnt + 255) >> 8) * 4;
        int incl = un;
#pragma unroll
        for (int o = 1; o < 32; o <<= 1) { const int t = __shfl_up(incl, o); if ((l & 31) >= o) incl += t; }
        if (l < 32) { cnts[l] = cnt; pre[l + 1] = incl; }
        if (l == 0) pre[0] = 0;
    }
    __syncthreads();
}

__device__ __forceinline__ int win_srccol(int nb) {
    const int pn = nb >> 3, q = nb & 7;
    if (pn < 4) return (pn >= 2 ? 512 : 0) + (4 * (pn & 1) + (q & 3)) * 64 + (q >> 2) * 32;
    if (pn < 10) return 1024 + (pn - 4) * 256 + 32 * q;
    const int j = pn - 10; return q < 4 ? 2560 + 128 * j + 32 * q : 3072 + 128 * j + 32 * (q - 4);
}
struct TileDesc { const float* sp; bf16_t* dp; int ldn, ldk; };
template <int KIND> __device__ __forceinline__ TileDesc tile_desc(const Args& a, int t, int lane) {
    const float* src; int ldn, col0, k0; bf16_t* dst; int ldk;
    if (KIND == 0) {
        const int isout = t >= 896 ? 1 : 0, u = t - 896 * isout, nb = u >> 3, kb = u & 7;
        src = (const float*)((const char*)a.w_in + ((const char*)a.w_out - (const char*)a.w_in) * (ptrdiff_t)isout); ldn = isout ? DM : INC; col0 = isout ? nb * 32 : win_srccol(nb); k0 = kb * 128;
        dst = (bf16_t*)((char*)a.WinT + ((char*)a.WoutT - (char*)a.WinT) * (ptrdiff_t)isout) + (size_t)nb * 32 * DM; ldk = DM;
    } else if (KIND == 1) {
        const int e = t >> 8, v = t & 255, nb = v >> 3, kb = v & 7, pn = nb >> 3, q = nb & 7;
        src = (const float*)((const char*)a.ewg + ((const char*)a.ewu - (const char*)a.ewg) * (ptrdiff_t)(q >> 2)) + (size_t)e * DM * DE; ldn = DE; col0 = 128 * pn + 32 * (q & 3); k0 = kb * 128; dst = a.W1T + ((size_t)e * 1024 + nb * 32) * DM; ldk = DM;
    } else {
        const int e = t >> 7, v = t & 127, nb = v >> 2, kb = v & 3;
        src = a.ewd + (size_t)e * DE * DM; ldn = DM; col0 = nb * 32; k0 = kb * 128; dst = a.W2T + ((size_t)e * 1024 + nb * 32) * DE; ldk = DE;
    }
    TileDesc d; d.sp = src + (size_t)(k0 + (lane >> 3)) * ldn + col0 + 4 * (lane & 7); d.dp = dst + k0 + 2 * lane; d.ldn = ldn; d.ldk = ldk; return d;
}
#define CT_LOAD(V, D) do { _Pragma("unroll") for (int i_ = 0; i_ < 16; ++i_) V[i_] = *(const f32x4*)((D).sp + (size_t)(8 * i_) * (D).ldn); } while (0)
#define CT_EMIT(V, D) do { \
        _Pragma("unroll") for (int i_ = 0; i_ < 16; ++i_) _Pragma("unroll") for (int j_ = 0; j_ < 4; ++j_) T[(4 * (lane & 7) + j_) * 130 + 8 * i_ + (lane >> 3)] = V[i_][j_]; \
        __builtin_amdgcn_wave_barrier(); \
        _Pragma("unroll") for (int nn_ = 0; nn_ < 32; ++nn_) { const float lo_ = T[nn_ * 130 + 2 * lane], hi_ = T[nn_ * 130 + 2 * lane + 1]; *(unsigned*)((D).dp + (size_t)nn_ * (D).ldk) = cvt_pk_bf16(lo_, hi_); } \
        __builtin_amdgcn_wave_barrier(); } while (0)
template <int KIND> __device__ __forceinline__ void convert_tiles(const Args& a, LAS float* T, int tbeg, int tend, int step, int lane) {
    if (tbeg >= tend) return;
    const int n = (tend - tbeg + step - 1) / step, tlast = tbeg + (n - 1) * step;
    f32x4 va[16], vb[16];
    TileDesc da = tile_desc<KIND>(a, tbeg, lane), db;
    CT_LOAD(va, da);
    for (int t = tbeg; t <= tlast; t += 2 * step) {
        const int t1 = t + step <= tlast ? t + step : tlast, t2 = t + 2 * step <= tlast ? t + 2 * step : tlast;
        db = tile_desc<KIND>(a, t1, lane);
        CT_LOAD(vb, db);
        CT_EMIT(va, da);
        da = tile_desc<KIND>(a, t2, lane);
        CT_LOAD(va, da);
        CT_EMIT(vb, db);
    }
}
__device__ __forceinline__ void phase_prep(const Args& a, LAS unsigned char* lds) {
    const int tid = threadIdx.x, lane = tid & 63, wid = tid >> 6;
    {
        LAS float* sc = (LAS float*)lds; LAS float* red = (LAS float*)(lds + 32768);
        for (int i = tid; i < NB * DM; i += NTHR) { const float v = a.c[i]; sc[i] = v / (1.f + __expf(-v)); }
        __syncthreads();
        for (int cg = blockIdx.x; cg < 256; cg += gridDim.x) {
            const int ks = tid / 6, c4 = tid % 6;
            if (tid < 510) {
                f32x4 ac[NB];
#pragma unroll
                for (int b = 0; b < NB; ++b) ac[b] = (f32x4){0.f, 0.f, 0.f, 0.f};
                for (int k = ks; k < DM; k += 85) {
                    const f32x4 w = *(const f32x4*)(a.ada_w + (size_t)k * MODW + cg * 24 + c4 * 4);
#pragma unroll
                    for (int b = 0; b < NB; ++b) ac[b] += w * sc[b * DM + k];
                }
#pragma unroll
                for (int b = 0; b < NB; ++b) *(LAS f32x4*)(red + (ks * 6 + c4) * 32 + b * 4) = ac[b];
            }
            __syncthreads();
            if (tid < 192) {
                const int b = tid / 24, col = tid % 24, cc = col >> 2, j = col & 3; float s = 0.f;
                for (int q = 0; q < 85; ++q) s += red[(q * 6 + cc) * 32 + b * 4 + j];
                a.mod[b * MODW + cg * 24 + col] = s + a.ada_b[cg * 24 + col];
            }
            __syncthreads();
        }
    }
    {
        for (int i = blockIdx.x * NTHR + tid; i < 48 * DM; i += gridDim.x * NTHR) {
            const int j = i >> 10, k = i & 1023; float v = 0.f;
            if (j < 4) v = a.rgw[k * 4 + j]; else if (j < 36) v = a.rew[k * 32 + (j - 4)];
            a.WrT[i] = (bf16_t)(cvt_pk_bf16(v, 0.f) & 0xffffu);
        }
    }
    {
        convert_tiles<0>(a, (LAS float*)(lds + wid * 16640), blockIdx.x * 8 + wid, 1152, gridDim.x * 8, lane);
        if (W1_PRE > 0) convert_tiles<1>(a, (LAS float*)(lds + wid * 16640), blockIdx.x * 8 + wid, W1_PRE, gridDim.x * 8, lane);
    }
}

__device__ __forceinline__ void load_mod_consts(const float* g, const float* mod_b, int shift_off, int scale_off, int lane, float (&Am)[16], float (&Bm)[16]) {
#pragma unroll
    for (int i = 0; i < 4; ++i) {
        const int k = 256 * i + 4 * lane;
        const f32x4 gv = *(const f32x4*)(g + k), sc = *(const f32x4*)(mod_b + scale_off + k), sh = *(const f32x4*)(mod_b + shift_off + k);
#pragma unroll
        for (int j = 0; j < 4; ++j) { Am[4 * i + j] = gv[j] * (1.f + sc[j]); Bm[4 * i + j] = sh[j]; }
    }
}
__device__ __forceinline__ void phase_norm1(const Args& a) {
    const int tid = threadIdx.x, lane = tid & 63, wid = tid >> 6, b = blockIdx.x >> 5;
    float Am[16], Bm[16];
    load_mod_consts(a.g_mix, a.mod + (size_t)b * MODW, 0, DM, lane, Am, Bm);
    for (int q = 0; q < 8; ++q) {
        const int row = blockIdx.x * 64 + wid * 8 + q;
        const float* xr = a.x + (size_t)row * DM + 4 * lane;
        f32x4 v[4]; float ss = 0.f;
#pragma unroll
        for (int i = 0; i < 4; ++i) { v[i] = *(const f32x4*)(xr + 256 * i); ss += v[i][0] * v[i][0] + v[i][1] * v[i][1] + v[i][2] * v[i][2] + v[i][3] * v[i][3]; }
        ss = wave_sum(ss);
        const float rs = __builtin_amdgcn_rsqf(ss * (1.f / DM) + 1e-6f);
        bf16_t* hr = a.h + (size_t)row * DM + 4 * lane;
#pragma unroll
        for (int i = 0; i < 4; ++i) {
            u32x2 w; w.x = cvt_pk_bf16(v[i][0] * rs * Am[4 * i] + Bm[4 * i], v[i][1] * rs * Am[4 * i + 1] + Bm[4 * i + 1]);
            w.y = cvt_pk_bf16(v[i][2] * rs * Am[4 * i + 2] + Bm[4 * i + 2], v[i][3] * rs * Am[4 * i + 3] + Bm[4 * i + 3]);
            *(u32x2*)(hr + 256 * i) = w;
        }
    }
}

constexpr int RLD = 72;
constexpr int RT = 64 * RLD * 2;
__device__ __forceinline__ bf16x8 lds_row8(const LAS unsigned char* base, int row, int col) { return *(const LAS bf16x8*)(base + (row * RLD + col) * 2); }
__device__ __forceinline__ bf16x8 lds_tr8(const LAS unsigned char* base, int kbase, int c16, int lane) {
    const int g = lane >> 4, q = (lane & 15) >> 2, p = lane & 3;
    const LAS unsigned char* ad = base + ((kbase + 8 * g + q) * RLD + 16 * c16 + 4 * p) * 2;
    const s16x4 lo = __builtin_amdgcn_ds_read_tr16_b64_v4i16((LAS s16x4*)ad);
    const s16x4 hi = __builtin_amdgcn_ds_read_tr16_b64_v4i16((LAS s16x4*)(ad + 4 * RLD * 2));
    return __builtin_shufflevector(lo, hi, 0, 1, 2, 3, 4, 5, 6, 7);
}
__device__ __forceinline__ u32x4 scale_bf16x8(u32x4 v, float s) {
    u32x4 r;
    r.x = cvt_pk_bf16(bf_lo(v.x) * s, bf_hi(v.x) * s); r.y = cvt_pk_bf16(bf_lo(v.y) * s, bf_hi(v.y) * s);
    r.z = cvt_pk_bf16(bf_lo(v.z) * s, bf_hi(v.z) * s); r.w = cvt_pk_bf16(bf_lo(v.w) * s, bf_hi(v.w) * s);
    return r;
}

__device__ __forceinline__ void phase_conv_seg(const Args& a, LAS unsigned char* lds) {
    const int tid = threadIdx.x, lane = tid & 63, wid = tid >> 6;
    {
        const int t0 = blockIdx.x * 64 + wid * 8, c0 = 8 * lane;
        float w0[8], w1[8], w2[8], cb[8], bt[8];
#pragma unroll
        for (int j = 0; j < 8; ++j) { w0[j] = a.conv_w[c0 + j]; w1[j] = a.conv_w[512 + c0 + j]; w2[j] = a.conv_w[1024 + c0 + j]; cb[j] = a.conv_b[c0 + j]; bt[j] = a.beta_conv[c0 + j]; }
        u32x4 um1 = (u32x4){0u, 0u, 0u, 0u}, um2 = um1;
        if ((t0 & (SEQ - 1)) != 0) { um1 = *(const u32x4*)(a.Up + (size_t)(t0 - 1) * 512 + c0); um2 = *(const u32x4*)(a.Up + (size_t)(t0 - 2) * 512 + c0); }
#pragma unroll 2
        for (int q = 0; q < 8; ++q) {
            const int t = t0 + q;
            const u32x4 uc = *(const u32x4*)(a.Up + (size_t)t * 512 + c0), bg = *(const u32x4*)(a.Bp + (size_t)t * 512 + c0);
            float y[8]; float ss = 0.f;
#pragma unroll
            for (int j2 = 0; j2 < 4; ++j2) {
                const unsigned cw = uc[j2], m1 = um1[j2], m2 = um2[j2], bw = bg[j2];
                const float y0 = bf_lo(bw) * (w0[2 * j2] * bf_lo(m2) + w1[2 * j2] * bf_lo(m1) + w2[2 * j2] * bf_lo(cw) + cb[2 * j2]);
                const float y1 = bf_hi(bw) * (w0[2 * j2 + 1] * bf_hi(m2) + w1[2 * j2 + 1] * bf_hi(m1) + w2[2 * j2 + 1] * bf_hi(cw) + cb[2 * j2 + 1]);
                y[2 * j2] = y0; y[2 * j2 + 1] = y1; ss += y0 * y0 + y1 * y1;
            }
            ss += __shfl_xor(ss, 1); ss += __shfl_xor(ss, 2); ss += __shfl_xor(ss, 4);
            const float rs = __builtin_amdgcn_rsqf(ss * (1.f / 64.f) + 1e-6f);
            u32x4 w; w.x = cvt_pk_bf16(y[0] * rs * bt[0], y[1] * rs * bt[1]); w.y = cvt_pk_bf16(y[2] * rs * bt[2], y[3] * rs * bt[3]);
            w.z = cvt_pk_bf16(y[4] * rs * bt[4], y[5] * rs * bt[5]); w.w = cvt_pk_bf16(y[6] * rs * bt[6], y[7] * rs * bt[7]);
            *(u32x4*)(a.Y + (size_t)t * DM + 512 + c0) = w;
            um2 = um1; um1 = uc;
        }
    }
    {
        const int u = blockIdx.x, b = u >> 5, hh = (u >> 2) & 7, seg = u & 3;
        const float l2g = __builtin_log2f(1.f - __builtin_amdgcn_exp2f(-5.f - (float)hh));
        const float cdec = __builtin_amdgcn_exp2f(l2g * 64.f);
        const int m = tid >> 3, c8 = (tid & 7) * 8;
        const float kdec = __builtin_amdgcn_exp2f(l2g * (float)(63 - m));
        const size_t tok0 = (size_t)b * SEQ + seg * 512;
        const int di = wid >> 1, ei0 = 2 * (wid & 1), g = lane >> 4;
        f32x4 st[2] = {(f32x4){0.f, 0.f, 0.f, 0.f}, (f32x4){0.f, 0.f, 0.f, 0.f}};
        u32x4 kr = *(const u32x4*)(a.Kp + (tok0 + m) * 512 + hh * 64 + c8), vr = *(const u32x4*)(a.Vp + (tok0 + m) * 512 + hh * 64 + c8);
        for (int j = 0; j < 8; ++j) {
            LAS unsigned char* Kd = lds + (j & 1) * 2 * RT; LAS unsigned char* Vs = Kd + RT;
            *(LAS u32x4*)(Kd + (m * RLD + c8) * 2) = scale_bf16x8(kr, kdec);
            *(LAS u32x4*)(Vs + (m * RLD + c8) * 2) = vr;
            __syncthreads();
            if (j + 1 < 8) { kr = *(const u32x4*)(a.Kp + (tok0 + (j + 1) * 64 + m) * 512 + hh * 64 + c8); vr = *(const u32x4*)(a.Vp + (tok0 + (j + 1) * 64 + m) * 512 + hh * 64 + c8); }
            st[0] *= cdec; st[1] *= cdec;
#pragma unroll
            for (int ks = 0; ks < 2; ++ks) {
                const bf16x8 af = lds_tr8(Kd, 32 * ks, di, lane);
#pragma unroll
                for (int e = 0; e < 2; ++e) { const bf16x8 bfv = lds_tr8(Vs, 32 * ks, ei0 + e, lane); st[e] = __builtin_amdgcn_mfma_f32_16x16x32_bf16(af, bfv, st[e], 0, 0, 0); }
            }
        }
        float* so = a.sseg + (size_t)u * 4096;
#pragma unroll
        for (int e = 0; e < 2; ++e)
#pragma unroll
            for (int r = 0; r < 4; ++r) __hip_atomic_store(so + (16 * di + 4 * g + r) * 64 + 16 * (ei0 + e) + (lane & 15), st[e][r], __ATOMIC_RELAXED, __HIP_MEMORY_SCOPE_AGENT);
        asm volatile("s_waitcnt vmcnt(0)" ::: "memory");
        __syncthreads();
        if (tid == 0) __hip_atomic_store(a.segflag + 16 * u, 1u, __ATOMIC_RELAXED, __HIP_MEMORY_SCOPE_AGENT);
    }
}

__device__ __forceinline__ void phase_ret_out(const Args& a, LAS unsigned char* lds) {
    const int tid = threadIdx.x, lane = tid & 63, wid = __builtin_amdgcn_readfirstlane(tid >> 6), g = lane >> 4, l15 = lane & 15;
    const int u = blockIdx.x, b = u >> 5, hh = (u >> 2) & 7, seg = u & 3;
    const float l2g = __builtin_log2f(1.f - __builtin_amdgcn_exp2f(-5.f - (float)hh));
    const float cdec = __builtin_amdgcn_exp2f(l2g * 64.f);
    const int m = tid >> 3, c8 = (tid & 7) * 8;
    const float kdec = __builtin_amdgcn_exp2f(l2g * (float)(63 - m));
    const size_t tok0 = (size_t)b * SEQ + seg * 512;
    LAS unsigned char* Ps = lds + 8 * RT; LAS unsigned char* Stb = lds + 9 * RT;
    f32x4 st[4];
#pragma unroll
    for (int e = 0; e < 4; ++e) st[e] = (f32x4){0.f, 0.f, 0.f, 0.f};
    float bt[16];
#pragma unroll
    for (int e = 0; e < 4; ++e)
#pragma unroll
        for (int r = 0; r < 4; ++r) bt[4 * e + r] = a.beta_ret[hh * 64 + 16 * e + 4 * g + r];
    if (seg > 0) {
        if (wid == 0) {
            unsigned sp = 0;
            for (int s2 = 0; s2 < seg; ++s2) {
                while (__builtin_amdgcn_readfirstlane(__hip_atomic_load(a.segflag + 16 * (u - seg + s2), __ATOMIC_RELAXED, __HIP_MEMORY_SCOPE_AGENT)) == 0u) {
                    __builtin_amdgcn_s_sleep(1);
                    if (++sp > (1u << 20)) { if (lane == 0) atomicAdd(&a.bar[XB_TMO], 1u); break; }
                }
            }
            __builtin_amdgcn_fence(__ATOMIC_ACQUIRE, "agent");
            asm volatile("s_waitcnt vmcnt(0)" ::: "memory");
        }
        __syncthreads();
    }
    if (wid >= 4) {
        const int di = wid - 4;
        for (int s2 = 0; s2 < seg; ++s2) {
            const float wgt = __builtin_amdgcn_exp2f(l2g * 512.f * (float)(seg - 1 - s2));
            const float* sp = a.sseg + (size_t)(u - seg + s2) * 4096;
#pragma unroll
            for (int e = 0; e < 4; ++e)
#pragma unroll
                for (int r = 0; r < 4; ++r) st[e][r] += wgt * sp[(16 * di + 4 * g + r) * 64 + 16 * e + l15];
        }
#pragma unroll
        for (int e = 0; e < 4; ++e) { u32x2 w; w.x = cvt_pk_bf16(st[e][0], st[e][1]); w.y = cvt_pk_bf16(st[e][2], st[e][3]); *(LAS u32x2*)(Stb + ((16 * e + l15) * RLD + 16 * di + 4 * g) * 2) = w; }
    }
    const bf16_t* qp = a.Qp + (tok0 + m) * 512 + hh * 64 + c8; const bf16_t* kp = a.Kp + (tok0 + m) * 512 + hh * 64 + c8; const bf16_t* vp = a.Vp + (tok0 + m) * 512 + hh * 64 + c8;
    u32x4 qr = *(const u32x4*)qp, kr = *(const u32x4*)kp, vr = *(const u32x4*)vp;
    for (int j = 0; j < 8; ++j) {
        LAS unsigned char* Qs = lds + (j & 1) * 4 * RT; LAS unsigned char* Ks = Qs + RT; LAS unsigned char* Kd = Qs + 2 * RT; LAS unsigned char* Vs = Qs + 3 * RT;
        LAS unsigned char* Stc = Stb + (j & 1) * RT; LAS unsigned char* Stn = Stb + ((j + 1) & 1) * RT;
        *(LAS u32x4*)(Qs + (m * RLD + c8) * 2) = qr; *(LAS u32x4*)(Ks + (m * RLD + c8) * 2) = kr;
        *(LAS u32x4*)(Kd + (m * RLD + c8) * 2) = scale_bf16x8(kr, kdec); *(LAS u32x4*)(Vs + (m * RLD + c8) * 2) = vr;
        __syncthreads();
        if (j + 1 < 8) { qr = *(const u32x4*)(qp + (size_t)(j + 1) * 64 * 512); kr = *(const u32x4*)(kp + (size_t)(j + 1) * 64 * 512); vr = *(const u32x4*)(vp + (size_t)(j + 1) * 64 * 512); }
        {
            const int mi = wid >> 1, ci0 = 2 * (wid & 1);
            f32x4 xs[2] = {(f32x4){0.f, 0.f, 0.f, 0.f}, (f32x4){0.f, 0.f, 0.f, 0.f}};
#pragma unroll
            for (int ks = 0; ks < 2; ++ks) {
                const bf16x8 af = lds_row8(Ks, 16 * mi + l15, 32 * ks + 8 * g);
#pragma unroll
                for (int c = 0; c < 2; ++c) { const bf16x8 bfv = lds_row8(Qs, 16 * (ci0 + c) + l15, 32 * ks + 8 * g); xs[c] = __builtin_amdgcn_mfma_f32_16x16x32_bf16(af, bfv, xs[c], 0, 0, 0); }
            }
#pragma unroll
            for (int c = 0; c < 2; ++c) {
                const int cc = 16 * (ci0 + c) + l15, mm = 16 * mi + 4 * g;
                float pv[4];
#pragma unroll
                for (int r = 0; r < 4; ++r) { const int d = cc - (mm + r); pv[r] = xs[c][r] * __builtin_amdgcn_exp2f(l2g * (float)(d < 0 ? -d : d)); }
                u32x2 w; w.x = cvt_pk_bf16(pv[0], pv[1]); w.y = cvt_pk_bf16(pv[2], pv[3]);
                *(LAS u32x2*)(Ps + (cc * RLD + mm) * 2) = w;
            }
        }
        __syncthreads();
        if (wid < 4) {
            const int cc = 16 * wid + l15; const size_t tok = tok0 + (size_t)j * 64 + cc;
            u32x2 gw[4];
#pragma unroll
            for (int e = 0; e < 4; ++e) gw[e] = *(const u32x2*)(a.Gp + tok * 512 + hh * 64 + 16 * e + 4 * g);
            f32x4 yi[4], ys[4];
#pragma unroll
            for (int e = 0; e < 4; ++e) { yi[e] = (f32x4){0.f, 0.f, 0.f, 0.f}; ys[e] = (f32x4){0.f, 0.f, 0.f, 0.f}; }
#pragma unroll
            for (int ks = 0; ks < 2; ++ks) {
                const bf16x8 pb = lds_row8(Ps, cc, 32 * ks + 8 * g), qb = lds_row8(Qs, cc, 32 * ks + 8 * g);
#pragma unroll
                for (int e = 0; e < 4; ++e) {
                    const bf16x8 va = lds_tr8(Vs, 32 * ks, e, lane);
                    yi[e] = __builtin_amdgcn_mfma_f32_16x16x32_bf16(va, pb, yi[e], 0, 0, 0);
                    const bf16x8 sa = lds_row8(Stc, 16 * e + l15, 32 * ks + 8 * g);
                    ys[e] = __builtin_amdgcn_mfma_f32_16x16x32_bf16(sa, qb, ys[e], 0, 0, 0);
                }
            }
            const float qdec = __builtin_amdgcn_exp2f(l2g * (float)(cc + 1));
            float sum = 0.f;
#pragma unroll
            for (int e = 0; e < 4; ++e) { yi[e] += ys[e] * qdec; sum += (yi[e][0] + yi[e][1]) + (yi[e][2] + yi[e][3]); }
            sum += __shfl_xor(sum, 16); sum += __shfl_xor(sum, 32);
            const float mu = sum * (1.f / 64.f); float vq = 0.f;
#pragma unroll
            for (int e = 0; e < 4; ++e) { const f32x4 d = yi[e] - mu; vq += (d[0] * d[0] + d[1] * d[1]) + (d[2] * d[2] + d[3] * d[3]); }
            vq += __shfl_xor(vq, 16); vq += __shfl_xor(vq, 32);
            const float rs = __builtin_amdgcn_rsqf(vq * (1.f / 64.f) + 1e-5f);
#pragma unroll
            for (int e = 0; e < 4; ++e) {
                const float g0 = bf_lo(gw[e].x), g1 = bf_hi(gw[e].x), g2 = bf_lo(gw[e].y), g3 = bf_hi(gw[e].y);
                u32x2 w; w.x = cvt_pk_bf16((yi[e][0] - mu) * rs * g0 * bt[4 * e], (yi[e][1] - mu) * rs * g1 * bt[4 * e + 1]);
                w.y = cvt_pk_bf16((yi[e][2] - mu) * rs * g2 * bt[4 * e + 2], (yi[e][3] - mu) * rs * g3 * bt[4 * e + 3]);
                *(u32x2*)(a.Y + tok * DM + hh * 64 + 16 * e + 4 * g) = w;
            }
        } else {
            const int di = wid - 4;
#pragma unroll
            for (int e = 0; e < 4; ++e) st[e] *= cdec;
#pragma unroll
            for (int ks = 0; ks < 2; ++ks) {
                const bf16x8 af = lds_tr8(Kd, 32 * ks, di, lane);
#pragma unroll
                for (int e = 0; e < 4; ++e) { const bf16x8 bfv = lds_tr8(Vs, 32 * ks, e, lane); st[e] = __builtin_amdgcn_mfma_f32_16x16x32_bf16(af, bfv, st[e], 0, 0, 0); }
            }
#pragma unroll
            for (int e = 0; e < 4; ++e) { u32x2 w; w.x = cvt_pk_bf16(st[e][0], st[e][1]); w.y = cvt_pk_bf16(st[e][2], st[e][3]); *(LAS u32x2*)(Stn + ((16 * e + l15) * RLD + 16 * di + 4 * g) * 2) = w; }
        }
    }
}

__device__ __forceinline__ void phase_norm2_router(const Args& a, LAS unsigned char* lds) {
    const int tid = threadIdx.x, lane = tid & 63, wid = __builtin_amdgcn_readfirstlane(tid >> 6), g = lane >> 4, l15 = lane & 15, b = blockIdx.x >> 5;
    constexpr int ALD = 1032;
    LAS unsigned char* At = lds;
    LAS float* part = (LAS float*)(lds + 66048);
    LAS float* logit = (LAS float*)(lds + 115200);
    LAS int* hist = (LAS int*)(lds + 121344);
    LAS int* hbase = (LAS int*)(lds + 121344 + 128);
    LAS int* selE = (LAS int*)(lds + 121344 + 256);
    LAS int* selS = (LAS int*)(lds + 121344 + 256 + 512);
    if (tid < 32) hist[tid] = 0;
    float Am[16], Bm[16];
    load_mod_consts(a.g_ffn, a.mod + (size_t)b * MODW, 3 * DM, 4 * DM, lane, Am, Bm);
    bf16x8 Bf[3][4];
#pragma unroll
    for (int nt = 0; nt < 3; ++nt)
#pragma unroll
        for (int ks = 0; ks < 4; ++ks) Bf[nt][ks] = *(const bf16x8*)(a.WrT + (size_t)(16 * nt + l15) * DM + 128 * wid + 32 * ks + 8 * g);
    const int row_base = blockIdx.x * 64;
    for (int it = 0; it < 2; ++it) {
#pragma unroll 1
        for (int q = 0; q < 4; ++q) {
            const int lr = 4 * wid + q, row = row_base + 32 * it + lr;
            const bf16_t* xr = a.x1b + (size_t)row * DM + 4 * lane;
            f32x4 v[4]; float ss = 0.f;
#pragma unroll
            for (int i = 0; i < 4; ++i) { const u32x2 xw = *(const u32x2*)(xr + 256 * i); v[i] = (f32x4){bf_lo(xw.x), bf_hi(xw.x), bf_lo(xw.y), bf_hi(xw.y)}; ss += v[i][0] * v[i][0] + v[i][1] * v[i][1] + v[i][2] * v[i][2] + v[i][3] * v[i][3]; }
            ss = wave_sum(ss);
            const float rs = __builtin_amdgcn_rsqf(ss * (1.f / DM) + 1e-6f);
            bf16_t* hr = a.h2 + (size_t)row * DM + 4 * lane;
#pragma unroll
            for (int i = 0; i < 4; ++i) {
                u32x2 w; w.x = cvt_pk_bf16(v[i][0] * rs * Am[4 * i] + Bm[4 * i], v[i][1] * rs * Am[4 * i + 1] + Bm[4 * i + 1]);
                w.y = cvt_pk_bf16(v[i][2] * rs * Am[4 * i + 2] + Bm[4 * i + 2], v[i][3] * rs * Am[4 * i + 3] + Bm[4 * i + 3]);
                *(u32x2*)(hr + 256 * i) = w;
                *(LAS u32x2*)(At + (lr * ALD + 256 * i + 4 * lane) * 2) = w;
            }
        }
        __syncthreads();
        {
            f32x4 pa[2][3];
#pragma unroll
            for (int mt = 0; mt < 2; ++mt)
#pragma unroll
                for (int nt = 0; nt < 3; ++nt) pa[mt][nt] = (f32x4){0.f, 0.f, 0.f, 0.f};
#pragma unroll
            for (int ks = 0; ks < 4; ++ks)
#pragma unroll
                for (int mt = 0; mt < 2; ++mt) {
                    const bf16x8 af = *(const LAS bf16x8*)(At + ((16 * mt + l15) * ALD + 128 * wid + 32 * ks + 8 * g) * 2);
#pragma unroll
                    for (int nt = 0; nt < 3; ++nt) pa[mt][nt] = __builtin_amdgcn_mfma_f32_16x16x32_bf16(af, Bf[nt][ks], pa[mt][nt], 0, 0, 0);
                }
#pragma unroll
            for (int mt = 0; mt < 2; ++mt)
#pragma unroll
                for (int nt = 0; nt < 3; ++nt)
#pragma unroll
                    for (int r = 0; r < 4; ++r) part[(wid * 32 + 16 * mt + 4 * g + r) * 48 + 16 * nt + l15] = pa[mt][nt][r];
        }
        __syncthreads();
        for (int idx = tid; idx < 32 * 48; idx += NTHR) {
            const int col = idx % 48; float s = 0.f;
#pragma unroll
            for (int w = 0; w < 8; ++w) s += part[w * 1536 + idx];
            if (col < 4) s += a.rgb[col]; else if (col < 36) s += a.reb[col - 4];
            logit[idx] = s;
        }
        __syncthreads();
        if (tid < 32) {
            const LAS float* lg = logit + tid * 48;
            int gi = 0; float gm = lg[0];
#pragma unroll
            for (int j = 1; j < 4; ++j) { const float v = lg[j]; if (v > gm) { gm = v; gi = j; } }
            float gs = 0.f;
#pragma unroll
            for (int j = 0; j < 4; ++j) gs += __expf(lg[j] - gm);
            const float gtop = 1.f / gs;
            const LAS float* el = lg + 4 + gi * 8;
            int i1 = 0; float l1 = el[0];
#pragma unroll
            for (int j = 1; j < 8; ++j) { const float v = el[j]; if (v > l1) { l1 = v; i1 = j; } }
            int i2 = 0; float l2 = -3.0e38f;
#pragma unroll
            for (int j = 0; j < 8; ++j) { const float v = el[j]; if (j != i1 && v > l2) { l2 = v; i2 = j; } }
            const float ex = __expf(l2 - l1);
            const float w1 = gtop / (1.f + ex), w2 = gtop * ex / (1.f + ex);
            const int e0 = gi * 8 + i1, e1 = gi * 8 + i2, tl = 32 * it + tid, t = row_base + tl;
            selE[2 * tl] = e0; selS[2 * tl] = atomicAdd((int*)&hist[e0], 1);
            selE[2 * tl + 1] = e1; selS[2 * tl + 1] = atomicAdd((int*)&hist[e1], 1);
            a.pw[2 * t] = w1; a.pw[2 * t + 1] = w2;
        }
    }
    __syncthreads();
    if (tid < 32) { const int n = hist[tid]; hbase[tid] = n ? atomicAdd(&a.counts[tid], n) : 0; }
    __syncthreads();
    if (tid < 128) { const int e = selE[tid]; a.lists[e * LCAP + hbase[e] + selS[tid]] = 2 * row_base + tid; }
}

__device__ __forceinline__ void phase_final(const Args& a, float* dst) {
    const int tid = threadIdx.x, lane = tid & 63, wid = tid >> 6, b = blockIdx.x >> 5;
    float gf[16], gn[16];
#pragma unroll
    for (int i = 0; i < 4; ++i) {
        const f32x4 g1 = *(const f32x4*)(a.mod + (size_t)b * MODW + 5 * DM + 256 * i + 4 * lane), g2 = *(const f32x4*)(a.g_fin + 256 * i + 4 * lane);
#pragma unroll
        for (int j = 0; j < 4; ++j) { gf[4 * i + j] = g1[j]; gn[4 * i + j] = g2[j]; }
    }
#pragma unroll 2
    for (int q = 0; q < 8; ++q) {
        const int row = blockIdx.x * 64 + wid * 8 + q;
        const bf16_t* xr = a.x1b + (size_t)row * DM + 4 * lane;
        const bf16_t* o0 = a.opair + (size_t)(2 * row) * DM + 4 * lane; const bf16_t* o1 = o0 + DM;
        f32x4 v[4]; float ss = 0.f;
#pragma unroll
        for (int i = 0; i < 4; ++i) {
            const u32x2 xw = *(const u32x2*)(xr + 256 * i); const f32x4 xv = (f32x4){bf_lo(xw.x), bf_hi(xw.x), bf_lo(xw.y), bf_hi(xw.y)}; const u32x2 pa = *(const u32x2*)(o0 + 256 * i), pb = *(const u32x2*)(o1 + 256 * i);
            v[i][0] = xv[0] + gf[4 * i] * (bf_lo(pa.x) + bf_lo(pb.x)); v[i][1] = xv[1] + gf[4 * i + 1] * (bf_hi(pa.x) + bf_hi(pb.x));
            v[i][2] = xv[2] + gf[4 * i + 2] * (bf_lo(pa.y) + bf_lo(pb.y)); v[i][3] = xv[3] + gf[4 * i + 3] * (bf_hi(pa.y) + bf_hi(pb.y));
            ss += v[i][0] * v[i][0] + v[i][1] * v[i][1] + v[i][2] * v[i][2] + v[i][3] * v[i][3];
        }
        ss = wave_sum(ss);
        const float rs = __builtin_amdgcn_rsqf(ss * (1.f / DM) + 1e-6f);
#pragma unroll
        for (int i = 0; i < 4; ++i) {
            f32x4 o; o[0] = v[i][0] * rs * gn[4 * i]; o[1] = v[i][1] * rs * gn[4 * i + 1]; o[2] = v[i][2] * rs * gn[4 * i + 2]; o[3] = v[i][3] * rs * gn[4 * i + 3];
            *(f32x4*)(dst + (size_t)row * DM + 4 * lane + 256 * i) = o;
        }
    }
}

#ifndef PROBE_DUP
#define PROBE_DUP 0
#endif
#define RUN(p) (a.p0 <= (p) && (p) < a.p1)
#define REP(p, ...) do { __VA_ARGS__ if constexpr (((PROBE_DUP) >> (p)) & 1) { __VA_ARGS__ } } while (0)
#define SYNC(p) do { if (a.p0 <= (p) && (p) + 1 < a.p1) { xcd_barrier(bar); if constexpr ((PROBE_DUP >> 16) & 1) xcd_barrier(bar); } } while (0)
__global__ void __launch_bounds__(NTHR, 2) mk_fwd(Args a) {
    extern __shared__ __attribute__((aligned(16))) unsigned char shm[];
    LAS unsigned char* lds = (LAS unsigned char*)shm;
    volatile LAS unsigned* xbw = (volatile LAS unsigned*)(lds + LDS_MISC);
    if (threadIdx.x < 4) xbw[threadIdx.x] = 0u;
    __syncthreads();
    XcdBarrier bar; bar.bar = a.bar; bar.x = 0; bar.st = xbw;
    if (a.p1 - a.p0 > 1) bar = xcd_barrier_post(a.bar, xbw);
    LAS int* mpre = (LAS int*)(lds + LDS_MISC + 64); LAS int* mcnt = (LAS int*)(lds + LDS_MISC + 64 + 256);

    if (RUN(0)) REP(0, { phase_prep(a, lds); __syncthreads(); });
    SYNC(0);
    if (RUN(1)) REP(1, phase_norm1(a););
    SYNC(1);
    if (RUN(2)) REP(2, { if (blockIdx.x >= NGEMM) { convert_tiles<1>(a, (LAS float*)(lds + (threadIdx.x >> 6) * 16640), W1_PRE + (blockIdx.x - NGEMM) * 8 + (threadIdx.x >> 6), 8192, (NWG - NGEMM) * 8, threadIdx.x & 63); } else {
        ProbInProj P; P.K = DM; P.S.init(NTOK, INC, NGEMM, blockIdx.x); P.A = (const char*)a.h; P.Bt = (const char*)a.WinT; P.pos = a.pos;
        P.Qp = a.Qp; P.Kp = a.Kp; P.Vp = a.Vp; P.Gp = a.Gp; P.Bp = a.Bp; P.Up = a.Up; pg8::gemm_phase(lds, P); } });
    SYNC(2);
    if (RUN(3)) REP(3, { phase_conv_seg(a, lds); __syncthreads(); });
    __syncthreads();
    if (RUN(4)) REP(4, { phase_ret_out(a, lds); __syncthreads(); });
    SYNC(4);
    if (RUN(5)) REP(5, { ProbOutProj P; P.K = DM; P.S.init(NTOK, DM, gridDim.x, blockIdx.x); P.A = (const char*)a.Y; P.Bt = (const char*)a.WoutT; P.x = a.x; P.mod = a.mod; P.x1 = a.x1b; pg8::gemm_phase(lds, P); });
    SYNC(5);
    if constexpr ((PROBE_DUP >> 6) & 1) { Args a2 = a; a2.counts = a.counts + 32; phase_norm2_router(a2, lds); __syncthreads(); }
    if (RUN(6)) phase_norm2_router(a, lds);
    SYNC(6);
    if (RUN(7)) REP(7, { if (blockIdx.x >= NGEMM) { convert_tiles<2>(a, (LAS float*)(lds + (threadIdx.x >> 6) * 16640), (blockIdx.x - NGEMM) * 8 + (threadIdx.x >> 6), 4096, (NWG - NGEMM) * 8, threadIdx.x & 63); } else {
        __syncthreads(); moe_tables(a.counts, mpre, mcnt);
        ProbMoe1 P; P.K = DM; P.S.pre = mpre; P.S.cnts = mcnt; P.S.G = NGEMM; P.S.c = blockIdx.x; P.S.NT = 4; P.A = (const char*)a.h2; P.Bt = (const char*)a.W1T; P.lists = a.lists; P.pw = a.pw; P.hid = a.hid; pg8::gemm_phase(lds, P); } });
    SYNC(7);
    if (RUN(8)) REP(8, { __syncthreads(); moe_tables(a.counts, mpre, mcnt);
        ProbMoe2 P; P.K = DE; P.S.pre = mpre; P.S.cnts = mcnt; P.S.G = gridDim.x; P.S.c = blockIdx.x; P.S.NT = 4; P.A = (const char*)a.hid; P.Bt = (const char*)a.W2T; P.lists = a.lists; P.opair = a.opair; pg8::gemm_phase(lds, P); });
    SYNC(8);
    if constexpr ((PROBE_DUP >> 9) & 1) { phase_final(a, (float*)a.W1T); }
    if (RUN(9)) phase_final(a, a.out);
}

extern "C" void kernel_launch(void* const* d_in, const int* in_sizes, int n_in, void* d_out, int out_size, void* d_ws, size_t ws_size, hipStream_t stream) {
    Args a; memset(&a, 0, sizeof(a));
    a.x = (const float*)d_in[0]; a.c = (const float*)d_in[1]; a.pos = (const int*)d_in[2]; a.ada_w = (const float*)d_in[3]; a.ada_b = (const float*)d_in[4];
    a.g_mix = (const float*)d_in[5]; a.g_ffn = (const float*)d_in[6]; a.w_in = (const float*)d_in[7]; a.conv_w = (const float*)d_in[8]; a.conv_b = (const float*)d_in[9];
    a.beta_ret = (const float*)d_in[10]; a.beta_conv = (const float*)d_in[11]; a.w_out = (const float*)d_in[12]; a.rgw = (const float*)d_in[13]; a.rgb = (const float*)d_in[14];
    a.rew = (const float*)d_in[15]; a.reb = (const float*)d_in[16]; a.ewg = (const float*)d_in[17]; a.ewu = (const float*)d_in[18]; a.ewd = (const float*)d_in[19]; a.g_fin = (const float*)d_in[20];
    a.out = (float*)d_out;
    char* ws = (char*)d_ws; size_t off = 0;
    auto carve = [&](size_t bytes) { void* p = ws + off; off += (bytes + 255) & ~(size_t)255; return p; };
    a.bar = (unsigned*)carve(XCD_BAR_WORDS * 4);
    a.counts = (int*)carve(256);
    a.segflag = (unsigned*)carve(256 * 64);
    const size_t zero_bytes = off;
    a.mod = (float*)carve((size_t)NB * MODW * 4);
    a.lists = (int*)carve((size_t)NE * LCAP * 4);
    a.pw = (float*)carve((size_t)2 * NTOK * 4);
    a.sseg = (float*)carve((size_t)256 * 4096 * 4);
    a.WrT = (bf16_t*)carve((size_t)48 * DM * 2);
    a.WinT = (bf16_t*)carve((size_t)INC * DM * 2);
    a.WoutT = (bf16_t*)carve((size_t)DM * DM * 2);
    a.W1T = (bf16_t*)carve((size_t)NE * 1024 * DM * 2);
    a.W2T = (bf16_t*)carve((size_t)NE * 1024 * DE * 2);
    a.h = (bf16_t*)carve((size_t)NTOK * DM * 2);
    bf16_t* big = (bf16_t*)carve((size_t)NTOK * 512 * 2 * 6);
    a.Y = (bf16_t*)carve((size_t)NTOK * DM * 2);
    if (off > ws_size) return;
    a.Qp = big; a.Kp = big + (size_t)NTOK * 512; a.Vp = big + (size_t)NTOK * 512 * 2; a.Gp = big + (size_t)NTOK * 512 * 3; a.Bp = big + (size_t)NTOK * 512 * 4; a.Up = big + (size_t)NTOK * 512 * 5;
    a.h2 = a.h; a.hid = a.Y; a.opair = big; a.x1b = big + (size_t)NTOK * 512 * 4;

    static bool attr = false;
    if (!attr) { (void)hipFuncSetAttribute((const void*)mk_fwd, hipFuncAttributeMaxDynamicSharedMemorySize, LDS_BYTES); attr = true; }
    (void)hipMemsetAsync(d_ws, 0, zero_bytes, stream);
#if MK_LAUNCHES == 1
    a.p0 = 0; a.p1 = 10;
    hipLaunchKernelGGL(mk_fwd, dim3(NWG), dim3(NTHR), LDS_BYTES, stream, a);
#else
    for (int p = 0; p < 10; ++p) { a.p0 = p; a.p1 = p + 1; hipLaunchKernelGGL(mk_fwd, dim3(NWG), dim3(NTHR), LDS_BYTES, stream, a); }
#endif
}
```

```cpp
#include <hip/hip_runtime.h>
#include <stdint.h>
#include <string.h>

#ifndef MK_LAUNCHES
#define MK_LAUNCHES 1
#endif

#define LAS __attribute__((address_space(3)))
typedef unsigned short bf16_t;
typedef short bf16x8 __attribute__((ext_vector_type(8)));
typedef short s16x4 __attribute__((ext_vector_type(4)));
typedef float f32x4 __attribute__((ext_vector_type(4)));
typedef unsigned u32x4 __attribute__((ext_vector_type(4)));
typedef unsigned u32x2 __attribute__((ext_vector_type(2)));
typedef int v4i_t __attribute__((ext_vector_type(4)));
typedef int v8i_t __attribute__((ext_vector_type(8)));

constexpr int DM = 1024, NB = 8, SEQ = 2048, NTOK = NB * SEQ, INC = 3584, NH = 8, NE = 32, DE = 512, MODW = 6144, LCAP = 16384;
constexpr int NWG = 256, NTHR = 512;
constexpr int NGEMM = 224;
#ifndef W2_PRE
#define W2_PRE 0
#endif
#ifndef W1_PRE
#define W1_PRE 4096
#endif
constexpr int LDS_BYTES = 147456;
constexpr int LDS_MISC = 146432;

#define XB_TMO      128
#define XB_XCNT(j)  (256  + 64 * (j))
#define XB_XSUB(j)  (1280 + 64 * (j))
#define XB_XGEN(j)  (2304 + 64 * (j))
#define XB_TOP      3328
#define XB_TOPGEN   3392
#define XCD_BAR_WORDS 3456
#define XB_SPIN_CAP (1u << 18)
__device__ __forceinline__ unsigned xb_ld(unsigned* p)              { return __hip_atomic_load(p, __ATOMIC_RELAXED, __HIP_MEMORY_SCOPE_AGENT); }
__device__ __forceinline__ unsigned xb_add(unsigned* p, unsigned v) { return __hip_atomic_fetch_add(p, v, __ATOMIC_RELAXED, __HIP_MEMORY_SCOPE_AGENT); }
__device__ __forceinline__ unsigned xb_xcc_id() { return (unsigned)__builtin_amdgcn_s_getreg((3 << 11) | 20) & 0xFu; }
#define XB_SPIN(cond, bar) do { unsigned _sp = 0; while (cond) { __builtin_amdgcn_s_sleep(1); \
    if ((++_sp & 255u) == 0u) { if (xb_ld(&(bar)[XB_TMO])) break; if (_sp > XB_SPIN_CAP) { atomicAdd(&(bar)[XB_TMO], 1u); break; } } } } while (0)
struct XcdBarrier { unsigned* bar; unsigned x; volatile LAS unsigned* st; };
__device__ __forceinline__ XcdBarrier xcd_barrier_post(unsigned* bar, volatile LAS unsigned* st) {
    XcdBarrier b; b.bar = bar; b.x = xb_xcc_id(); b.st = st;
    if (threadIdx.x == 0) (void)xb_add(&bar[XB_XCNT(b.x)], 1u);
    return b;
}
__device__ __forceinline__ void xcd_barrier_complete(unsigned* bar, unsigned x, unsigned& nloc, unsigned& nx) {
    const unsigned G = gridDim.x * gridDim.y * gridDim.z;
    unsigned sum, cnt, mine, sp = 0u;
    for (;;) {
        sum = 0u; cnt = 0u; mine = 0u;
#pragma unroll
        for (unsigned j = 0; j < 16; ++j) { const unsigned c = xb_ld(&bar[XB_XCNT(j)]); sum += c; cnt += (c > 0u) ? 1u : 0u; mine = (j == x) ? c : mine; }
        if (sum == G) break;
        __builtin_amdgcn_s_sleep(1);
        if ((++sp & 255u) == 0u) { if (xb_ld(&bar[XB_TMO])) break; if (sp > XB_SPIN_CAP) { atomicAdd(&bar[XB_TMO], 1u); break; } }
    }
    nloc = mine > 0u ? mine : 1u; nx = cnt > 0u ? cnt : 1u;
}
__device__ __forceinline__ void xcd_barrier(const XcdBarrier& b) {
    asm volatile("s_waitcnt vmcnt(0)" ::: "memory");
    __syncthreads();
    if (threadIdx.x == 0) {
        unsigned* bar = b.bar;
        __builtin_amdgcn_s_waitcnt(0);
        unsigned nloc = b.st[0], nx = b.st[1];
        if (nloc == 0u) { xcd_barrier_complete(bar, b.x, nloc, nx); b.st[0] = nloc; b.st[1] = nx; }
        const unsigned old = xb_add(&bar[XB_XSUB(b.x)], 1u);
        const unsigned gen = old / nloc;
        if (old + 1u == (gen + 1u) * nloc) {
            __builtin_amdgcn_fence(__ATOMIC_RELEASE, "agent");
            asm volatile("s_waitcnt vmcnt(0)" ::: "memory");
            const unsigned og = xb_add(&bar[XB_TOP], 1u);
            const unsigned tg = og / nx;
            if (og + 1u == (tg + 1u) * nx) xb_add(&bar[XB_TOPGEN], 1u);
            else XB_SPIN(xb_ld(&bar[XB_TOPGEN]) == tg, bar);
            __builtin_amdgcn_fence(__ATOMIC_ACQUIRE, "agent");
            xb_add(&bar[XB_XGEN(b.x)], 1u);
            asm volatile("s_waitcnt vmcnt(0)" ::: "memory");
        } else {
            XB_SPIN(xb_ld(&bar[XB_XGEN(b.x)]) == gen, bar);
            __builtin_amdgcn_fence(__ATOMIC_ACQUIRE, "agent");
            asm volatile("s_waitcnt vmcnt(0)" ::: "memory");
        }
    }
    __syncthreads();
}

typedef __bf16 bf16x2_t __attribute__((ext_vector_type(2)));
typedef float f32x2_t __attribute__((ext_vector_type(2)));
__device__ __forceinline__ unsigned cvt_pk_bf16(float lo, float hi) { const f32x2_t f = {lo, hi}; return __builtin_bit_cast(unsigned, __builtin_convertvector(f, bf16x2_t)); }
__device__ __forceinline__ float bf_lo(unsigned w) { return __uint_as_float(w << 16); }
__device__ __forceinline__ float bf_hi(unsigned w) { return __uint_as_float(w & 0xffff0000u); }
__device__ __forceinline__ float fast_silu(float x) { return x * __builtin_amdgcn_rcpf(1.f + __builtin_amdgcn_exp2f(-1.44269504089f * x)); }
__device__ __forceinline__ float wave_sum(float v) {
#pragma unroll
    for (int o = 32; o >= 1; o >>= 1) v += __shfl_xor(v, o);
    return v;
}

struct Args {
    const float *x, *c; const int* pos;
    const float *ada_w, *ada_b, *g_mix, *g_ffn, *w_in, *conv_w, *conv_b, *beta_ret, *beta_conv, *w_out, *rgw, *rgb, *rew, *reb, *ewg, *ewu, *ewd, *g_fin;
    float* out;
    unsigned* bar; int* counts; unsigned* segflag; float* mod; int* lists; float* pw; float* sseg;
    bf16_t *WinT, *WoutT, *W1T, *W2T, *WrT;
    bf16_t *h, *Qp, *Kp, *Vp, *Gp, *Bp, *Up, *Y, *h2, *hid, *opair, *x1b;
    unsigned char *h2q, *hidq, *W1Q, *W2Q;
    int p0, p1;
};

namespace pg8 {
constexpr int BM = 256, BK = 64, HALF = 128, HTB = HALF * BK * 2, STAGE_BYTES = 8 * HTB;
__device__ __forceinline__ int lds_byte(int r, int c) { const int st = (r >> 4) * 2 + (c >> 5), rr = r & 15, cc = c & 31, ob = rr * 64 + cc * 2; return st * 1024 + (ob ^ (((ob >> 9) & 1) << 5)); }
__device__ __forceinline__ void stage_rc(int b, int& R, int& C) { const int st = b / 1024, sb = b % 1024, swz = sb ^ (((sb >> 9) & 1) << 5); R = (st >> 1) * 16 + swz / 64; C = (st & 1) * 32 + (swz % 64) / 2; }
__device__ __forceinline__ int perm32(int rho) { const int n = rho >> 4, i = rho & 15; return 8 * (i >> 2) + 4 * n + (i & 3); }

struct Unit { int pm, pn, e, cnt; };

template <class P>
__device__ __forceinline__ void gemm_phase(LAS unsigned char* lds, const P& prob) {
    const int tid = threadIdx.x, wid = __builtin_amdgcn_readfirstlane(tid >> 6), lane = tid & 63, wr = wid >> 2, wc = wid & 3, fr = lane & 15, fq = lane >> 4;
    const int K = prob.K, nt = K / BK;
    int RA[2]; unsigned CA2[2], voffB[2];
#pragma unroll
    for (int i = 0; i < 2; ++i) { int R, C; stage_rc(tid * 16 + i * 8192, R, C); const int Rb = P::PERM ? ((R & ~31) + perm32(R & 31)) : R;
        RA[i] = R; CA2[i] = (unsigned)C * 2u; voffB[i] = (unsigned)(Rb * K + C) * 2u; }
    const unsigned kstep = (unsigned)(BK * 2);
    const size_t hstep = (size_t)HALF * K * 2;
    const unsigned ldsw = (unsigned)wid * 1024u;
    const int aoff = lds_byte(wr * 64 + fr, fq * 8), boff = lds_byte(wc * 32 + fr, fq * 8);
#define PG8_SA(b, h) (((b) * 2 + (h)) * HTB)
#define PG8_SB(b, h) ((4 + (b) * 2 + (h)) * HTB)
#define PG8_STAGE_B(bufoff, gbase) do { _Pragma("unroll") for (int _i = 0; _i < 2; ++_i) \
        __builtin_amdgcn_global_load_lds((const unsigned*)((const char*)(gbase) + voffB[_i]), (LAS unsigned*)(lds + (bufoff) + ldsw + _i * 8192), 16, 0, 0); } while (0)
#define PG8_STAGE_A(bufoff, offh, kb) do { _Pragma("unroll") for (int _i = 0; _i < 2; ++_i) \
        __builtin_amdgcn_global_load_lds((const unsigned*)(Ab + (size_t)((offh)[_i] + (kb))), (LAS unsigned*)(lds + (bufoff) + ldsw + _i * 8192), 16, 0, 0); } while (0)
#define PG8_LDA(dst, b, h) do { _Pragma("unroll") for (int m = 0; m < 4; ++m) _Pragma("unroll") for (int k = 0; k < 2; ++k) dst[m][k] = *(const LAS bf16x8*)(lds + PG8_SA(b, h) + aoff + m * 2048 + k * 1024); } while (0)
#define PG8_LDB(dst, b, h) do { _Pragma("unroll") for (int n = 0; n < 2; ++n) _Pragma("unroll") for (int k = 0; k < 2; ++k) dst[n][k] = *(const LAS bf16x8*)(lds + PG8_SB(b, h) + boff + n * 2048 + k * 1024); } while (0)
#define PG8_MMA(ai, bj, At, Bt) do { __builtin_amdgcn_s_setprio(1); _Pragma("unroll") for (int m = 0; m < 4; ++m) _Pragma("unroll") for (int n = 0; n < 2; ++n) _Pragma("unroll") for (int k = 0; k < 2; ++k) \
        acc[ai][bj][m][n] = __builtin_amdgcn_mfma_f32_16x16x32_bf16(Bt[n][k], At[m][k], acc[ai][bj][m][n], 0, 0, 0); __builtin_amdgcn_s_setprio(0); } while (0)
#define PG8_WAIT_V(n) asm volatile("s_waitcnt vmcnt(" #n ")" ::: "memory")
#define PG8_WAIT_L(n) asm volatile("s_waitcnt lgkmcnt(" #n ")" ::: "memory")
#define PG8_BAR __builtin_amdgcn_s_barrier()
#define PG8_SCHED __builtin_amdgcn_sched_barrier(0)
    Unit cur, nxt; int ui = 0;
    if (!prob.next(0, cur)) return;
    f32x4 acc[2][2][4][2];
#pragma unroll
    for (int a = 0; a < 2; ++a)
#pragma unroll
        for (int b = 0; b < 2; ++b)
#pragma unroll
            for (int m = 0; m < 4; ++m)
#pragma unroll
                for (int n = 0; n < 2; ++n) acc[a][b][m][n] = (f32x4){0.f, 0.f, 0.f, 0.f};
    bf16x8 At[4][2], B0[2][2], B1[2][2];
    const char* Ab = prob.a_base();
    unsigned cO0[2], cO1[2], nO0[2], nO1[2];
#pragma unroll
    for (int i = 0; i < 2; ++i) { cO0[i] = prob.a_row(cur, RA[i]) + CA2[i]; cO1[i] = prob.a_row(cur, HALF + RA[i]) + CA2[i]; }
    const char* cB = prob.b_tile(cur);
    PG8_STAGE_B(PG8_SB(0, 0), cB); PG8_STAGE_A(PG8_SA(0, 0), cO0, 0u); PG8_STAGE_B(PG8_SB(0, 1), cB + hstep); PG8_STAGE_A(PG8_SA(0, 1), cO1, 0u);
    if (wr == 1) PG8_BAR;
    PG8_WAIT_V(4); PG8_BAR;
    PG8_STAGE_B(PG8_SB(1, 0), cB + kstep); PG8_STAGE_A(PG8_SA(1, 0), cO0, kstep); PG8_STAGE_B(PG8_SB(1, 1), cB + hstep + kstep);
    PG8_WAIT_V(6); PG8_BAR;
    for (;;) {
        const bool has_next = prob.next(ui + 1, nxt);
        const char* nB = cB;
#pragma unroll
        for (int i = 0; i < 2; ++i) { nO0[i] = cO0[i]; nO1[i] = cO1[i]; }
        if (has_next) {
            nB = prob.b_tile(nxt);
#pragma unroll
            for (int i = 0; i < 2; ++i) { nO0[i] = prob.a_row(nxt, RA[i]) + CA2[i]; nO1[i] = prob.a_row(nxt, HALF + RA[i]) + CA2[i]; }
        }
        for (int t = 0; t < nt; t += 2) {
            const bool last = (t == nt - 2);
            const unsigned k1 = (unsigned)(t + 1) * kstep;
            const unsigned k2 = last ? 0u : (unsigned)(t + 2) * kstep, k3 = k2 + kstep;
            unsigned o20[2], o21[2];
#pragma unroll
            for (int i = 0; i < 2; ++i) { o20[i] = last ? nO0[i] : cO0[i]; o21[i] = last ? nO1[i] : cO1[i]; }
            const char* b2 = last ? nB : cB + (size_t)(t + 2) * kstep; const char* b3 = b2 + kstep;
            PG8_LDB(B0, 0, 0); PG8_SCHED; PG8_LDA(At, 0, 0); PG8_STAGE_A(PG8_SA(1, 1), cO1, k1);
            PG8_WAIT_L(8); PG8_BAR; PG8_WAIT_L(0); PG8_MMA(0, 0, At, B0); PG8_BAR; PG8_SCHED;
            PG8_LDB(B1, 0, 1); PG8_STAGE_B(PG8_SB(0, 0), b2);
            PG8_BAR; PG8_WAIT_L(0); PG8_MMA(0, 1, At, B1); PG8_BAR;
            PG8_LDA(At, 0, 1); PG8_STAGE_A(PG8_SA(0, 0), o20, k2);
            PG8_BAR; PG8_WAIT_L(0); PG8_MMA(1, 0, At, B0); PG8_BAR; PG8_SCHED;
            PG8_STAGE_B(PG8_SB(0, 1), b2 + hstep);
            PG8_WAIT_V(6); PG8_BAR; PG8_MMA(1, 1, At, B1); PG8_BAR;
            PG8_LDB(B0, 1, 0); PG8_SCHED; PG8_LDA(At, 1, 0); PG8_STAGE_A(PG8_SA(0, 1), o21, k2);
            PG8_WAIT_L(8); PG8_BAR; PG8_WAIT_L(0); PG8_MMA(0, 0, At, B0); PG8_BAR; PG8_SCHED;
            PG8_LDB(B1, 1, 1); PG8_STAGE_B(PG8_SB(1, 0), b3);
            PG8_BAR; PG8_WAIT_L(0); PG8_MMA(0, 1, At, B1); PG8_BAR;
            PG8_LDA(At, 1, 1); PG8_STAGE_A(PG8_SA(1, 0), o20, k3);
            PG8_BAR; PG8_WAIT_L(0); PG8_MMA(1, 0, At, B0); PG8_BAR; PG8_SCHED;
            PG8_STAGE_B(PG8_SB(1, 1), b3 + hstep);
            PG8_WAIT_V(6); PG8_BAR; PG8_MMA(1, 1, At, B1); PG8_BAR;
        }
        prob.epi(acc, cur, wr, wc, fr, fq);
        if (!has_next) break;
#pragma unroll
        for (int a = 0; a < 2; ++a)
#pragma unroll
            for (int b = 0; b < 2; ++b)
#pragma unroll
                for (int m = 0; m < 4; ++m)
#pragma unroll
                    for (int n = 0; n < 2; ++n) acc[a][b][m][n] = (f32x4){0.f, 0.f, 0.f, 0.f};
        cur = nxt; cB = nB; ++ui;
#pragma unroll
        for (int i = 0; i < 2; ++i) { cO0[i] = nO0[i]; cO1[i] = nO1[i]; }
    }
    PG8_WAIT_V(0);
    if (wr == 0) PG8_BAR;
    PG8_BAR;
#undef PG8_SA
#undef PG8_SB
#undef PG8_STAGE_A
#undef PG8_STAGE_B
#undef PG8_LDA
#undef PG8_LDB
#undef PG8_MMA
#undef PG8_WAIT_V
#undef PG8_WAIT_L
#undef PG8_BAR
#undef PG8_SCHED
}

template <class P>
__device__ __forceinline__ void gemm_phase_f8(LAS unsigned char* lds, const P& prob) {
    const int tid = threadIdx.x, wid = __builtin_amdgcn_readfirstlane(tid >> 6), lane = tid & 63, wr = wid >> 2, wc = wid & 3, fr = lane & 15, fq = lane >> 4;
    const int K = prob.K, nt = K / BK;
    int RA[2]; unsigned CA2[2], voffB[2];
#pragma unroll
    for (int i = 0; i < 2; ++i) { int R, C; stage_rc(tid * 16 + i * 8192, R, C); const int Rb = P::PERM ? ((R & ~31) + perm32(R & 31)) : R;
        RA[i] = R; CA2[i] = (unsigned)C * 2u; voffB[i] = (unsigned)(Rb * K + C) * 2u; }
    const unsigned kstep = (unsigned)(BK * 2);
    const size_t hstep = (size_t)HALF * K * 2;
    const unsigned ldsw = (unsigned)wid * 1024u;
    const int aoff = lds_byte(wr * 64 + fr, fq * 8), boff = lds_byte(wc * 32 + fr, fq * 8);
#define PG8_SA(b, h) (((b) * 2 + (h)) * HTB)
#define PG8_SB(b, h) ((4 + (b) * 2 + (h)) * HTB)
#define PG8_STAGE_B(bufoff, gbase) do { _Pragma("unroll") for (int _i = 0; _i < 2; ++_i) \
        __builtin_amdgcn_global_load_lds((const unsigned*)((const char*)(gbase) + voffB[_i]), (LAS unsigned*)(lds + (bufoff) + ldsw + _i * 8192), 16, 0, 0); } while (0)
#define PG8_STAGE_A(bufoff, offh, kb) do { _Pragma("unroll") for (int _i = 0; _i < 2; ++_i) \
        __builtin_amdgcn_global_load_lds((const unsigned*)(Ab + (size_t)((offh)[_i] + (kb))), (LAS unsigned*)(lds + (bufoff) + ldsw + _i * 8192), 16, 0, 0); } while (0)
#define PG8_LD8(base) __builtin_shufflevector(*(const LAS v4i_t*)(base), *(const LAS v4i_t*)((base) + 1024), 0, 1, 2, 3, 4, 5, 6, 7)
#define PG8_LDA(dst, b, h) do { _Pragma("unroll") for (int m = 0; m < 4; ++m) dst[m] = PG8_LD8(lds + PG8_SA(b, h) + aoff + m * 2048); } while (0)
#define PG8_LDB(dst, b, h) do { _Pragma("unroll") for (int n = 0; n < 2; ++n) dst[n] = PG8_LD8(lds + PG8_SB(b, h) + boff + n * 2048); } while (0)
#define PG8_MMA(ai, bj, At, Bt) do { __builtin_amdgcn_s_setprio(1); _Pragma("unroll") for (int m = 0; m < 4; ++m) _Pragma("unroll") for (int n = 0; n < 2; ++n) \
        asm volatile("v_mfma_scale_f32_16x16x128_f8f6f4 %0, %1, %2, %0, %3, %4 op_sel_hi:[0,0,0]" : "+v"(acc[ai][bj][m][n]) : "v"(Bt[n]), "v"(At[m]), "v"(wsc), "v"(asc)); \
        __builtin_amdgcn_s_setprio(0); } while (0)
#define PG8_WAIT_V(n) asm volatile("s_waitcnt vmcnt(" #n ")" ::: "memory")
#define PG8_WAIT_L(n) asm volatile("s_waitcnt lgkmcnt(" #n ")" ::: "memory")
#define PG8_BAR __builtin_amdgcn_s_barrier()
#define PG8_SCHED __builtin_amdgcn_sched_barrier(0)
    Unit cur, nxt; int ui = 0; const int wsc = 0x7B7B7B7B, asc = P::ASC;
    if (!prob.next(0, cur)) return;
    f32x4 acc[2][2][4][2];
#pragma unroll
    for (int a = 0; a < 2; ++a)
#pragma unroll
        for (int b = 0; b < 2; ++b)
#pragma unroll
            for (int m = 0; m < 4; ++m)
#pragma unroll
                for (int n = 0; n < 2; ++n) acc[a][b][m][n] = (f32x4){0.f, 0.f, 0.f, 0.f};
    v8i_t At[4], B0[2], B1[2];
    const char* Ab = prob.a_base();
    unsigned cO0[2], cO1[2], nO0[2], nO1[2];
#pragma unroll
    for (int i = 0; i < 2; ++i) { cO0[i] = prob.a_row(cur, RA[i]) + CA2[i]; cO1[i] = prob.a_row(cur, HALF + RA[i]) + CA2[i]; }
    const char* cB = prob.b_tile(cur);
    PG8_STAGE_B(PG8_SB(0, 0), cB); PG8_STAGE_A(PG8_SA(0, 0), cO0, 0u); PG8_STAGE_B(PG8_SB(0, 1), cB + hstep); PG8_STAGE_A(PG8_SA(0, 1), cO1, 0u);
    if (wr == 1) PG8_BAR;
    PG8_WAIT_V(4); PG8_BAR;
    PG8_STAGE_B(PG8_SB(1, 0), cB + kstep); PG8_STAGE_A(PG8_SA(1, 0), cO0, kstep); PG8_STAGE_B(PG8_SB(1, 1), cB + hstep + kstep);
    PG8_WAIT_V(6); PG8_BAR;
    for (;;) {
        const bool has_next = prob.next(ui + 1, nxt);
        const char* nB = cB;
#pragma unroll
        for (int i = 0; i < 2; ++i) { nO0[i] = cO0[i]; nO1[i] = cO1[i]; }
        if (has_next) {
            nB = prob.b_tile(nxt);
#pragma unroll
            for (int i = 0; i < 2; ++i) { nO0[i] = prob.a_row(nxt, RA[i]) + CA2[i]; nO1[i] = prob.a_row(nxt, HALF + RA[i]) + CA2[i]; }
        }
        for (int t = 0; t < nt; t += 2) {
            const bool last = (t == nt - 2);
            const unsigned k1 = (unsigned)(t + 1) * kstep;
            const unsigned k2 = last ? 0u : (unsigned)(t + 2) * kstep, k3 = k2 + kstep;
            unsigned o20[2], o21[2];
#pragma unroll
            for (int i = 0; i < 2; ++i) { o20[i] = last ? nO0[i] : cO0[i]; o21[i] = last ? nO1[i] : cO1[i]; }
            const char* b2 = last ? nB : cB + (size_t)(t + 2) * kstep; const char* b3 = b2 + kstep;
            PG8_LDB(B0, 0, 0); PG8_SCHED; PG8_LDA(At, 0, 0); PG8_STAGE_A(PG8_SA(1, 1), cO1, k1);
            PG8_WAIT_L(8); PG8_BAR; PG8_WAIT_L(0); PG8_MMA(0, 0, At, B0); PG8_BAR; PG8_SCHED;
            PG8_LDB(B1, 0, 1); PG8_STAGE_B(PG8_SB(0, 0), b2);
            PG8_BAR; PG8_WAIT_L(0); PG8_MMA(0, 1, At, B1); PG8_BAR;
            PG8_LDA(At, 0, 1); PG8_STAGE_A(PG8_SA(0, 0), o20, k2);
            PG8_BAR; PG8_WAIT_L(0); PG8_MMA(1, 0, At, B0); PG8_BAR; PG8_SCHED;
            PG8_STAGE_B(PG8_SB(0, 1), b2 + hstep);
            PG8_WAIT_V(6); PG8_BAR; PG8_MMA(1, 1, At, B1); PG8_BAR;
            PG8_LDB(B0, 1, 0); PG8_SCHED; PG8_LDA(At, 1, 0); PG8_STAGE_A(PG8_SA(0, 1), o21, k2);
            PG8_WAIT_L(8); PG8_BAR; PG8_WAIT_L(0); PG8_MMA(0, 0, At, B0); PG8_BAR; PG8_SCHED;
            PG8_LDB(B1, 1, 1); PG8_STAGE_B(PG8_SB(1, 0), b3);
            PG8_BAR; PG8_WAIT_L(0); PG8_MMA(0, 1, At, B1); PG8_BAR;
            PG8_LDA(At, 1, 1); PG8_STAGE_A(PG8_SA(1, 0), o20, k3);
            PG8_BAR; PG8_WAIT_L(0); PG8_MMA(1, 0, At, B0); PG8_BAR; PG8_SCHED;
            PG8_STAGE_B(PG8_SB(1, 1), b3 + hstep);
            PG8_WAIT_V(6); PG8_BAR; PG8_MMA(1, 1, At, B1); PG8_BAR;
        }
        asm volatile("s_nop 7\n\ts_nop 7" ::: "memory");
        prob.epi(acc, cur, wr, wc, fr, fq);
        if (!has_next) break;
#pragma unroll
        for (int a = 0; a < 2; ++a)
#pragma unroll
            for (int b = 0; b < 2; ++b)
#pragma unroll
                for (int m = 0; m < 4; ++m)
#pragma unroll
                    for (int n = 0; n < 2; ++n) acc[a][b][m][n] = (f32x4){0.f, 0.f, 0.f, 0.f};
        cur = nxt; cB = nB; ++ui;
#pragma unroll
        for (int i = 0; i < 2; ++i) { cO0[i] = nO0[i]; cO1[i] = nO1[i]; }
    }
    PG8_WAIT_V(0);
    if (wr == 0) PG8_BAR;
    PG8_BAR;
#undef PG8_SA
#undef PG8_SB
#undef PG8_STAGE_A
#undef PG8_STAGE_B
#undef PG8_LDA
#undef PG8_LDB
#undef PG8_MMA
#undef PG8_LD8
#undef PG8_WAIT_V
#undef PG8_WAIT_L
#undef PG8_BAR
#undef PG8_SCHED
}


struct StaticOrder {
    int nM, nN, nwg, G, c;
    __device__ void init(int M, int N, int G_, int c_) { nM = M / BM; nN = N / BM; nwg = nM * nN; G = G_; c = c_; }
    __device__ bool next(int i, Unit& u) const {
        const long L = (long)i * G + c; if (L >= nwg) return false;
        int wgid = (int)L; { const int q = nwg / 8, r = nwg % 8, xcd = wgid % 8, off = wgid / 8; wgid = (xcd < r ? xcd * (q + 1) : r * (q + 1) + (xcd - r) * q) + off; }
        const int nig = 8 * nN, gid = wgid / nig, fm = gid * 8, gsz = (nM - fm) < 8 ? (nM - fm) : 8;
        u.pm = fm + ((wgid % nig) % gsz); u.pn = (wgid % nig) / gsz; u.e = 0; u.cnt = 256; return true;
    }
};
}
using pg8::Unit;
typedef f32x4 AccT[2][2][4][2];

struct ProbInProj {
    static constexpr bool PERM = true;
    int K; pg8::StaticOrder S; const char* A; const char* Bt; const int* pos; bf16_t *Qp, *Kp, *Vp, *Gp, *Bp, *Up;
    __device__ __forceinline__ bool next(int i, Unit& u) const { return S.next(i, u); }
    __device__ __forceinline__ const char* a_base() const { return A; }
    __device__ __forceinline__ unsigned a_row(const Unit& u, int r) const { return (unsigned)(u.pm * 256 + r) * (unsigned)(DM * 2); }
    __device__ __forceinline__ const char* b_tile(const Unit& u) const { return Bt + (size_t)u.pn * 256 * DM * 2; }
    __device__ __forceinline__ void epi(const AccT& acc, const Unit& u, int wr, int wc, int fr, int fq) const {
        const int row0 = u.pm * 256 + wr * 64 + fr, pn = u.pn;
        if (pn < 4) {
            bf16_t* dst = Qp + (size_t)(pn >> 1) * ((size_t)NTOK * 512); const float sc = pn >= 2 ? 0.125f : 1.0f; const int head = 4 * (pn & 1) + wc;
            float invf[8];
#pragma unroll
            for (int q = 0; q < 8; ++q) invf[q] = __builtin_amdgcn_exp2f(-(float)(8 * fq + q) * (13.287712379549449f / 32.f)) * 0.15915494309189535f;
#pragma unroll
            for (int ai = 0; ai < 2; ++ai)
#pragma unroll
                for (int m = 0; m < 4; ++m) {
                    const int tok = row0 + ai * 128 + m * 16; const float p = (float)pos[tok];
                    float o1[8], o2[8];
#pragma unroll
                    for (int n = 0; n < 2; ++n)
#pragma unroll
                        for (int j = 0; j < 4; ++j) {
                            float rev = p * invf[4 * n + j]; rev = rev - __builtin_floorf(rev);
                            const float sn = __builtin_amdgcn_sinf(rev), cs = __builtin_amdgcn_cosf(rev);
                            const float t1 = acc[ai][0][m][n][j], t2 = acc[ai][1][m][n][j];
                            o1[4 * n + j] = (t1 * cs - t2 * sn) * sc; o2[4 * n + j] = (t2 * cs + t1 * sn) * sc;
                        }
                    bf16_t* rp = dst + (size_t)tok * 512 + head * 64 + 8 * fq;
                    u32x4 w1, w2;
                    w1.x = cvt_pk_bf16(o1[0], o1[1]); w1.y = cvt_pk_bf16(o1[2], o1[3]); w1.z = cvt_pk_bf16(o1[4], o1[5]); w1.w = cvt_pk_bf16(o1[6], o1[7]);
                    w2.x = cvt_pk_bf16(o2[0], o2[1]); w2.y = cvt_pk_bf16(o2[2], o2[3]); w2.z = cvt_pk_bf16(o2[4], o2[5]); w2.w = cvt_pk_bf16(o2[6], o2[7]);
                    *(u32x4*)rp = w1; *(u32x4*)(rp + 32) = w2;
                }
        } else if (pn < 10) {
            const int grp = (pn - 4) >> 1; bf16_t* dst = Vp + (size_t)grp * ((size_t)NTOK * 512); const bool act = grp == 1;
            const int col0 = (pn & 1) * 256 + wc * 32 + 8 * fq;
#pragma unroll
            for (int ai = 0; ai < 2; ++ai)
#pragma unroll
                for (int m = 0; m < 4; ++m) {
                    bf16_t* rp = dst + (size_t)(row0 + ai * 128 + m * 16) * 512 + col0;
#pragma unroll
                    for (int bj = 0; bj < 2; ++bj) {
                        f32x4 v0 = acc[ai][bj][m][0], v1 = acc[ai][bj][m][1];
                        if (act) {
#pragma unroll
                            for (int j = 0; j < 4; ++j) { v0[j] = fast_silu(v0[j]); v1[j] = fast_silu(v1[j]); }
                        }
                        u32x4 w; w.x = cvt_pk_bf16(v0[0], v0[1]); w.y = cvt_pk_bf16(v0[2], v0[3]); w.z = cvt_pk_bf16(v1[0], v1[1]); w.w = cvt_pk_bf16(v1[2], v1[3]);
                        *(u32x4*)(rp + bj * 128) = w;
                    }
                }
        } else {
            const int ch0 = 128 * (pn - 10) + wc * 32 + 8 * fq;
#pragma unroll
            for (int ai = 0; ai < 2; ++ai)
#pragma unroll
                for (int m = 0; m < 4; ++m) {
                    const f32x4 v0 = acc[ai][0][m][0] * acc[ai][1][m][0], v1 = acc[ai][0][m][1] * acc[ai][1][m][1];
                    u32x4 w; w.x = cvt_pk_bf16(v0[0], v0[1]); w.y = cvt_pk_bf16(v0[2], v0[3]); w.z = cvt_pk_bf16(v1[0], v1[1]); w.w = cvt_pk_bf16(v1[2], v1[3]);
                    *(u32x4*)(Up + (size_t)(row0 + ai * 128 + m * 16) * 512 + ch0) = w;
                }
        }
    }
};

struct ProbOutProj {
    static constexpr bool PERM = true;
    int K; pg8::StaticOrder S; const char* A; const char* Bt; const float* x; const float* mod; bf16_t* x1;
    __device__ __forceinline__ bool next(int i, Unit& u) const { return S.next(i, u); }
    __device__ __forceinline__ const char* a_base() const { return A; }
    __device__ __forceinline__ unsigned a_row(const Unit& u, int r) const { return (unsigned)(u.pm * 256 + r) * (unsigned)(DM * 2); }
    __device__ __forceinline__ const char* b_tile(const Unit& u) const { return Bt + (size_t)u.pn * 256 * DM * 2; }
    __device__ __forceinline__ void epi(const AccT& acc, const Unit& u, int wr, int wc, int fr, int fq) const {
        const int row0 = u.pm * 256 + wr * 64 + fr, col0 = u.pn * 256 + wc * 32 + 8 * fq;
        const float* gate = mod + (size_t)(u.pm >> 3) * MODW + 2 * DM;
        f32x4 gv[2][2];
#pragma unroll
        for (int bj = 0; bj < 2; ++bj)
#pragma unroll
            for (int n = 0; n < 2; ++n) gv[bj][n] = *(const f32x4*)(gate + col0 + bj * 128 + n * 4);
#pragma unroll
        for (int ai = 0; ai < 2; ++ai)
#pragma unroll
            for (int m = 0; m < 4; ++m) {
                const size_t off = (size_t)(row0 + ai * 128 + m * 16) * DM + col0;
#pragma unroll
                for (int bj = 0; bj < 2; ++bj) {
                    const f32x4 x0 = *(const f32x4*)(x + off + bj * 128), x1v = *(const f32x4*)(x + off + bj * 128 + 4);
                    const f32x4 v0 = x0 + gv[bj][0] * acc[ai][bj][m][0], v1 = x1v + gv[bj][1] * acc[ai][bj][m][1];
                    u32x4 w; w.x = cvt_pk_bf16(v0[0], v0[1]); w.y = cvt_pk_bf16(v0[2], v0[3]); w.z = cvt_pk_bf16(v1[0], v1[1]); w.w = cvt_pk_bf16(v1[2], v1[3]);
                    *(u32x4*)(x1 + off + bj * 128) = w;
                }
            }
    }
};

struct MoeOrder {
    const LAS int* pre;
    const LAS int* cnts;
    int G, c, NT;
    __device__ __forceinline__ bool next(int i, Unit& u) const {
        int L = i * G + c;
        const int total = __builtin_amdgcn_readfirstlane(pre[32]);
        if (L >= total) return false;
        { const int q = total >> 3, r = total & 7, xcd = L & 7, off = L >> 3; L = (xcd < r ? xcd * (q + 1) : r * (q + 1) + (xcd - r) * q) + off; }
        int e = 0;
        for (int j = 1; j < 32; ++j) e += (__builtin_amdgcn_readfirstlane(pre[j]) <= L) ? 1 : 0;
        const int cnt = __builtin_amdgcn_readfirstlane(cnts[e]), tiles = (cnt + 255) >> 8, local = L - __builtin_amdgcn_readfirstlane(pre[e]);
        u.e = e; u.cnt = cnt; u.pn = local / tiles; u.pm = local - u.pn * tiles; return true;
    }
};
struct ProbMoe1 {
    static constexpr bool PERM = true; static constexpr int ASC = 0x7F7F7F7F;
    int K; MoeOrder S; const char* A; const char* Bt; const int* lists; const float* pw; bf16_t* hid;
    __device__ __forceinline__ bool next(int i, Unit& u) const { return S.next(i, u); }
    __device__ __forceinline__ const char* a_base() const { return A; }
    __device__ __forceinline__ unsigned a_row(const Unit& u, int r) const { int s = u.pm * 256 + r; s = s < u.cnt ? s : u.cnt - 1; const int p = lists[u.e * LCAP + s]; return (unsigned)(p >> 1) * (unsigned)DM; }
    __device__ __forceinline__ const char* b_tile(const Unit& u) const { return Bt + ((size_t)u.e * 4 + u.pn) * 256 * DM; }
    __device__ __forceinline__ void epi(const AccT& acc, const Unit& u, int wr, int wc, int fr, int fq) const {
        const int col0 = u.pn * 128 + wc * 32 + 8 * fq;
#pragma unroll
        for (int ai = 0; ai < 2; ++ai)
#pragma unroll
            for (int m = 0; m < 4; ++m) {
                const int s = u.pm * 256 + ai * 128 + wr * 64 + m * 16 + fr;
                if (s < u.cnt) {
                    const int p = lists[u.e * LCAP + s]; const float w = pw[p];
                    const f32x4 a0 = acc[ai][0][m][0], a1 = acc[ai][0][m][1], u0 = acc[ai][1][m][0], u1 = acc[ai][1][m][1];
                    float o[8];
#pragma unroll
                    for (int j = 0; j < 4; ++j) { o[j] = fast_silu(a0[j]) * u0[j] * w; o[4 + j] = fast_silu(a1[j]) * u1[j] * w; }
                    int q0 = __builtin_amdgcn_cvt_pk_fp8_f32(o[0] * 8.f, o[1] * 8.f, 0, false); q0 = __builtin_amdgcn_cvt_pk_fp8_f32(o[2] * 8.f, o[3] * 8.f, q0, true);
                    int q1 = __builtin_amdgcn_cvt_pk_fp8_f32(o[4] * 8.f, o[5] * 8.f, 0, false); q1 = __builtin_amdgcn_cvt_pk_fp8_f32(o[6] * 8.f, o[7] * 8.f, q1, true);
                    u32x2 wv; wv.x = (unsigned)q0; wv.y = (unsigned)q1;
                    *(u32x2*)((unsigned char*)hid + (size_t)p * DE + col0) = wv;
                }
            }
    }
};
struct ProbMoe2 {
    static constexpr bool PERM = true; static constexpr int ASC = 0x7C7C7C7C;
    int K; MoeOrder S; const char* A; const char* Bt; const int* lists; bf16_t* opair;
    __device__ __forceinline__ bool next(int i, Unit& u) const { return S.next(i, u); }
    __device__ __forceinline__ const char* a_base() const { return A; }
    __device__ __forceinline__ unsigned a_row(const Unit& u, int r) const { int s = u.pm * 256 + r; s = s < u.cnt ? s : u.cnt - 1; const int p = lists[u.e * LCAP + s]; return (unsigned)p * (unsigned)DE; }
    __device__ __forceinline__ const char* b_tile(const Unit& u) const { return Bt + ((size_t)u.e * 4 + u.pn) * 256 * DE; }
    __device__ __forceinline__ void epi(const AccT& acc, const Unit& u, int wr, int wc, int fr, int fq) const {
        const int col0 = u.pn * 256 + wc * 32 + 8 * fq;
#pragma unroll
        for (int ai = 0; ai < 2; ++ai)
#pragma unroll
            for (int m = 0; m < 4; ++m) {
                const int s = u.pm * 256 + ai * 128 + wr * 64 + m * 16 + fr;
                if (s < u.cnt) {
                    const int p = lists[u.e * LCAP + s];
                    bf16_t* rp = opair + (size_t)p * DM + col0;
#pragma unroll
                    for (int bj = 0; bj < 2; ++bj) {
                        const f32x4 v0 = acc[ai][bj][m][0], v1 = acc[ai][bj][m][1];
                        u32x4 w; w.x = cvt_pk_bf16(v0[0], v0[1]); w.y = cvt_pk_bf16(v0[2], v0[3]); w.z = cvt_pk_bf16(v1[0], v1[1]); w.w = cvt_pk_bf16(v1[2], v1[3]);
                        *(u32x4*)(rp + bj * 128) = w;
                    }
                }
            }
    }
};
__device__ __forceinline__ void moe_tables(const int* counts, LAS int* pre, LAS int* cnts) {
    if (threadIdx.x < 64) {
        const int l = threadIdx.x; const int cnt = l < 32 ? counts[l] : 0; const int un = ((cnt + 255) >> 8) * 4;
        int incl = un;
#pragma unroll
        for (int o = 1; o < 32; o <<= 1) { const int t = __shfl_up(incl, o); if ((l & 31) >= o) incl += t; }
        if (l < 32) { cnts[l] = cnt; pre[l + 1] = incl; }
        if (l == 0) pre[0] = 0;
    }
    __syncthreads();
}

__device__ __forceinline__ int win_srccol(int nb) {
    const int pn = nb >> 3, q = nb & 7;
    if (pn < 4) return (pn >= 2 ? 512 : 0) + (4 * (pn & 1) + (q & 3)) * 64 + (q >> 2) * 32;
    if (pn < 10) return 1024 + (pn - 4) * 256 + 32 * q;
    const int j = pn - 10; return q < 4 ? 2560 + 128 * j + 32 * q : 3072 + 128 * j + 32 * (q - 4);
}
struct TileDesc { __amdgpu_buffer_rsrc_t rs, rd; unsigned rstep, dstep; };
template <int KIND> __device__ __forceinline__ TileDesc tile_desc(const Args& a, int tt) {
    const int t = __builtin_amdgcn_readfirstlane(tt);
    const float* src; int ldn, col0, k0; bf16_t* dst; int ldk;
    if (KIND == 0) {
        const int isout = t >= 896 ? 1 : 0, u = t - 896 * isout, nb = u >> 3, kb = u & 7;
        src = (const float*)((const char*)a.w_in + ((const char*)a.w_out - (const char*)a.w_in) * (ptrdiff_t)isout); ldn = isout ? DM : INC; col0 = isout ? nb * 32 : win_srccol(nb); k0 = kb * 128;
        dst = (bf16_t*)((char*)a.WinT + ((char*)a.WoutT - (char*)a.WinT) * (ptrdiff_t)isout) + (size_t)nb * 32 * DM; ldk = DM;
    } else if (KIND == 1) {
        const int e = t >> 8, v = t & 255, nb = v >> 3, kb = v & 7, pn = nb >> 3, q = nb & 7;
        src = (const float*)((const char*)a.ewg + ((const char*)a.ewu - (const char*)a.ewg) * (ptrdiff_t)(q >> 2)) + (size_t)e * DM * DE; ldn = DE; col0 = 128 * pn + 32 * (q & 3); k0 = kb * 128;
        dst = (bf16_t*)(a.W1Q + ((size_t)e * 1024 + nb * 32) * DM) ; ldk = DM / 2;
    } else {
        const int e = t >> 7, v = t & 127, nb = v >> 2, kb = v & 3;
        src = a.ewd + (size_t)e * DE * DM; ldn = DM; col0 = nb * 32; k0 = kb * 128;
        dst = (bf16_t*)(a.W2Q + ((size_t)e * 1024 + nb * 32) * DE); ldk = DE / 2;
    }
    TileDesc d;
    d.rs = __builtin_amdgcn_make_buffer_rsrc((void*)(src + (size_t)k0 * ldn + col0), 0, 128 * ldn * 4, 0x00020000);
    d.rd = __builtin_amdgcn_make_buffer_rsrc(KIND == 0 ? (void*)(dst + k0) : (void*)((unsigned char*)dst + k0), 0, 32 * ldk * 2, 0x00020000);
    d.rstep = (unsigned)(8 * ldn * 4); d.dstep = (unsigned)(ldk * 2);
    return d;
}
#define CT_LOAD(V, D) do { const unsigned vo_ = ((unsigned)(lane >> 3) * ((D).rstep >> 3)) + 16u * (unsigned)(lane & 7); \
        _Pragma("unroll") for (int i_ = 0; i_ < 16; ++i_) V[i_] = __builtin_bit_cast(f32x4, __builtin_amdgcn_raw_buffer_load_b128((D).rs, (int)vo_, (int)(i_ * (D).rstep), 0)); } while (0)
#define CT_EMIT(V, D) do { \
        _Pragma("unroll") for (int i_ = 0; i_ < 16; ++i_) _Pragma("unroll") for (int j_ = 0; j_ < 4; ++j_) T[(4 * (lane & 7) + j_) * 130 + 8 * i_ + (lane >> 3)] = V[i_][j_]; \
        __builtin_amdgcn_wave_barrier(); \
        _Pragma("unroll") for (int nn_ = 0; nn_ < 32; ++nn_) { const float lo_ = T[nn_ * 130 + 2 * lane], hi_ = T[nn_ * 130 + 2 * lane + 1]; \
            __builtin_amdgcn_raw_buffer_store_b32(cvt_pk_bf16(lo_, hi_), (D).rd, 4 * lane, (int)(nn_ * (D).dstep), 0); } \
        __builtin_amdgcn_wave_barrier(); } while (0)
#define CT_EMIT8(V, D) do { \
        _Pragma("unroll") for (int i_ = 0; i_ < 16; ++i_) _Pragma("unroll") for (int j_ = 0; j_ < 4; ++j_) T[(4 * (lane & 7) + j_) * 130 + 8 * i_ + (lane >> 3)] = V[i_][j_]; \
        __builtin_amdgcn_wave_barrier(); \
        _Pragma("unroll") for (int it_ = 0; it_ < 16; ++it_) { const LAS float* tp_ = T + (2 * it_ + (lane >> 5)) * 130 + 4 * (lane & 31); \
            int pk_ = __builtin_amdgcn_cvt_pk_fp8_f32(tp_[0] * 16.f, tp_[1] * 16.f, 0, false); pk_ = __builtin_amdgcn_cvt_pk_fp8_f32(tp_[2] * 16.f, tp_[3] * 16.f, pk_, true); \
            __builtin_amdgcn_raw_buffer_store_b32((unsigned)pk_, (D).rd, (int)((unsigned)(lane >> 5) * (D).dstep + 4u * (unsigned)(lane & 31)), (int)(2 * it_ * (D).dstep), 0); } \
        __builtin_amdgcn_wave_barrier(); } while (0)
#define CT_EMITK(V, D) do { if (KIND == 0) CT_EMIT(V, D); else CT_EMIT8(V, D); } while (0)
template <int KIND> __device__ __forceinline__ void convert_tiles(const Args& a, LAS float* T, int tbeg, int tend, int step, int lane) {
    if (tbeg >= tend) return;
    const int n = (tend - tbeg + step - 1) / step, n3 = (n / 3) * 3;
    int t = tbeg;
    if (n3 > 0) {
        const int tl3 = tbeg + (n3 - 1) * step;
        f32x4 va[16], vb[16], vc[16];
        TileDesc da = tile_desc<KIND>(a, t), db = tile_desc<KIND>(a, t + step), dc;
        CT_LOAD(va, da); CT_LOAD(vb, db);
        for (; t <= tl3; t += 3 * step) {
            const int t3 = t + 3 * step <= tl3 ? t + 3 * step : tl3, t4 = t + 4 * step <= tl3 ? t + 4 * step : tl3;
            dc = tile_desc<KIND>(a, t + 2 * step); CT_LOAD(vc, dc);
            CT_EMITK(va, da);
            da = tile_desc<KIND>(a, t3); CT_LOAD(va, da);
            CT_EMITK(vb, db);
            db = tile_desc<KIND>(a, t4); CT_LOAD(vb, db);
            CT_EMITK(vc, dc);
        }
    }
    for (; t < tend; t += step) { f32x4 v[16]; const TileDesc d = tile_desc<KIND>(a, t); CT_LOAD(v, d); CT_EMITK(v, d); }
}
__device__ __forceinline__ void phase_prep(const Args& a, LAS unsigned char* lds) {
    const int tid = threadIdx.x, lane = tid & 63, wid = tid >> 6;
    {
        LAS float* sc = (LAS float*)lds; LAS float* red = (LAS float*)(lds + 32768);
        for (int i = tid; i < NB * DM; i += NTHR) { const float v = a.c[i]; sc[i] = v / (1.f + __expf(-v)); }
        __syncthreads();
        for (int cg = blockIdx.x; cg < 256; cg += gridDim.x) {
            const int ks = tid / 6, c4 = tid % 6;
            if (tid < 510) {
                f32x4 ac[NB];
#pragma unroll
                for (int b = 0; b < NB; ++b) ac[b] = (f32x4){0.f, 0.f, 0.f, 0.f};
                for (int k = ks; k < DM; k += 85) {
                    const f32x4 w = *(const f32x4*)(a.ada_w + (size_t)k * MODW + cg * 24 + c4 * 4);
#pragma unroll
                    for (int b = 0; b < NB; ++b) ac[b] += w * sc[b * DM + k];
                }
#pragma unroll
                for (int b = 0; b < NB; ++b) *(LAS f32x4*)(red + (ks * 6 + c4) * 32 + b * 4) = ac[b];
            }
            __syncthreads();
            if (tid < 192) {
                const int b = tid / 24, col = tid % 24, cc = col >> 2, j = col & 3; float s = 0.f;
                for (int q = 0; q < 85; ++q) s += red[(q * 6 + cc) * 32 + b * 4 + j];
                a.mod[b * MODW + cg * 24 + col] = s + a.ada_b[cg * 24 + col];
            }
            __syncthreads();
        }
    }
    {
        for (int i = blockIdx.x * NTHR + tid; i < 48 * DM; i += gridDim.x * NTHR) {
            const int j = i >> 10, k = i & 1023; float v = 0.f;
            if (j < 4) v = a.rgw[k * 4 + j]; else if (j < 36) v = a.rew[k * 32 + (j - 4)];
            a.WrT[i] = (bf16_t)(cvt_pk_bf16(v, 0.f) & 0xffffu);
        }
    }
    {
        convert_tiles<0>(a, (LAS float*)(lds + wid * 16640), blockIdx.x * 8 + wid, 1152, gridDim.x * 8, lane);
        if (W1_PRE > 0) convert_tiles<1>(a, (LAS float*)(lds + wid * 16640), blockIdx.x * 8 + wid, W1_PRE, gridDim.x * 8, lane);
        if (W2_PRE > 0) convert_tiles<2>(a, (LAS float*)(lds + wid * 16640), blockIdx.x * 8 + wid, W2_PRE, gridDim.x * 8, lane);
    }
}

__device__ __forceinline__ void load_mod_consts(const float* g, const float* mod_b, int shift_off, int scale_off, int lane, float (&Am)[16], float (&Bm)[16]) {
#pragma unroll
    for (int i = 0; i < 4; ++i) {
        const int k = 256 * i + 4 * lane;
        const f32x4 gv = *(const f32x4*)(g + k), sc = *(const f32x4*)(mod_b + scale_off + k), sh = *(const f32x4*)(mod_b + shift_off + k);
#pragma unroll
        for (int j = 0; j < 4; ++j) { Am[4 * i + j] = gv[j] * (1.f + sc[j]); Bm[4 * i + j] = sh[j]; }
    }
}
__device__ __forceinline__ void phase_norm1(const Args& a) {
    const int tid = threadIdx.x, lane = tid & 63, wid = tid >> 6, b = blockIdx.x >> 5;
    float Am[16], Bm[16];
    load_mod_consts(a.g_mix, a.mod + (size_t)b * MODW, 0, DM, lane, Am, Bm);
    for (int q = 0; q < 8; ++q) {
        const int row = blockIdx.x * 64 + wid * 8 + q;
        const float* xr = a.x + (size_t)row * DM + 4 * lane;
        f32x4 v[4]; float ss = 0.f;
#pragma unroll
        for (int i = 0; i < 4; ++i) { v[i] = *(const f32x4*)(xr + 256 * i); ss += v[i][0] * v[i][0] + v[i][1] * v[i][1] + v[i][2] * v[i][2] + v[i][3] * v[i][3]; }
        ss = wave_sum(ss);
        const float rs = __builtin_amdgcn_rsqf(ss * (1.f / DM) + 1e-6f);
        bf16_t* hr = a.h + (size_t)row * DM + 4 * lane;
#pragma unroll
        for (int i = 0; i < 4; ++i) {
            u32x2 w; w.x = cvt_pk_bf16(v[i][0] * rs * Am[4 * i] + Bm[4 * i], v[i][1] * rs * Am[4 * i + 1] + Bm[4 * i + 1]);
            w.y = cvt_pk_bf16(v[i][2] * rs * Am[4 * i + 2] + Bm[4 * i + 2], v[i][3] * rs * Am[4 * i + 3] + Bm[4 * i + 3]);
            *(u32x2*)(hr + 256 * i) = w;
        }
    }
}

constexpr int RLD = 72;
constexpr int RT = 64 * RLD * 2;
__device__ __forceinline__ bf16x8 lds_row8(const LAS unsigned char* base, int row, int col) { return *(const LAS bf16x8*)(base + (row * RLD + col) * 2); }
__device__ __forceinline__ bf16x8 lds_tr8(const LAS unsigned char* base, int kbase, int c16, int lane) {
    const int g = lane >> 4, q = (lane & 15) >> 2, p = lane & 3;
    const LAS unsigned char* ad = base + ((kbase + 8 * g + q) * RLD + 16 * c16 + 4 * p) * 2;
    const s16x4 lo = __builtin_amdgcn_ds_read_tr16_b64_v4i16((LAS s16x4*)ad);
    const s16x4 hi = __builtin_amdgcn_ds_read_tr16_b64_v4i16((LAS s16x4*)(ad + 4 * RLD * 2));
    return __builtin_shufflevector(lo, hi, 0, 1, 2, 3, 4, 5, 6, 7);
}
__device__ __forceinline__ u32x4 scale_bf16x8(u32x4 v, float s) {
    u32x4 r;
    r.x = cvt_pk_bf16(bf_lo(v.x) * s, bf_hi(v.x) * s); r.y = cvt_pk_bf16(bf_lo(v.y) * s, bf_hi(v.y) * s);
    r.z = cvt_pk_bf16(bf_lo(v.z) * s, bf_hi(v.z) * s); r.w = cvt_pk_bf16(bf_lo(v.w) * s, bf_hi(v.w) * s);
    return r;
}

__device__ __forceinline__ void phase_conv_seg(const Args& a, LAS unsigned char* lds) {
    const int tid = threadIdx.x, lane = tid & 63, wid = tid >> 6;
    {
        const int t0 = blockIdx.x * 64 + wid * 8, c0 = 8 * lane;
        float w0[8], w1[8], w2[8], cb[8], bt[8];
#pragma unroll
        for (int j = 0; j < 8; ++j) { w0[j] = a.conv_w[c0 + j]; w1[j] = a.conv_w[512 + c0 + j]; w2[j] = a.conv_w[1024 + c0 + j]; cb[j] = a.conv_b[c0 + j]; bt[j] = a.beta_conv[c0 + j]; }
        u32x4 um1 = (u32x4){0u, 0u, 0u, 0u}, um2 = um1;
        if ((t0 & (SEQ - 1)) != 0) { um1 = *(const u32x4*)(a.Up + (size_t)(t0 - 1) * 512 + c0); um2 = *(const u32x4*)(a.Up + (size_t)(t0 - 2) * 512 + c0); }
#pragma unroll 2
        for (int q = 0; q < 8; ++q) {
            const int t = t0 + q;
            const u32x4 uc = *(const u32x4*)(a.Up + (size_t)t * 512 + c0), bg = *(const u32x4*)(a.Bp + (size_t)t * 512 + c0);
            float y[8]; float ss = 0.f;
#pragma unroll
            for (int j2 = 0; j2 < 4; ++j2) {
                const unsigned cw = uc[j2], m1 = um1[j2], m2 = um2[j2], bw = bg[j2];
                const float y0 = bf_lo(bw) * (w0[2 * j2] * bf_lo(m2) + w1[2 * j2] * bf_lo(m1) + w2[2 * j2] * bf_lo(cw) + cb[2 * j2]);
                const float y1 = bf_hi(bw) * (w0[2 * j2 + 1] * bf_hi(m2) + w1[2 * j2 + 1] * bf_hi(m1) + w2[2 * j2 + 1] * bf_hi(cw) + cb[2 * j2 + 1]);
                y[2 * j2] = y0; y[2 * j2 + 1] = y1; ss += y0 * y0 + y1 * y1;
            }
            ss += __shfl_xor(ss, 1); ss += __shfl_xor(ss, 2); ss += __shfl_xor(ss, 4);
            const float rs = __builtin_amdgcn_rsqf(ss * (1.f / 64.f) + 1e-6f);
            u32x4 w; w.x = cvt_pk_bf16(y[0] * rs * bt[0], y[1] * rs * bt[1]); w.y = cvt_pk_bf16(y[2] * rs * bt[2], y[3] * rs * bt[3]);
            w.z = cvt_pk_bf16(y[4] * rs * bt[4], y[5] * rs * bt[5]); w.w = cvt_pk_bf16(y[6] * rs * bt[6], y[7] * rs * bt[7]);
            *(u32x4*)(a.Y + (size_t)t * DM + 512 + c0) = w;
            um2 = um1; um1 = uc;
        }
    }
    {
        const int u = blockIdx.x, b = u >> 5, hh = (u >> 2) & 7, seg = u & 3;
        const float l2g = __builtin_log2f(1.f - __builtin_amdgcn_exp2f(-5.f - (float)hh));
        const float cdec = __builtin_amdgcn_exp2f(l2g * 64.f);
        const int m = tid >> 3, c8 = (tid & 7) * 8;
        const float kdec = __builtin_amdgcn_exp2f(l2g * (float)(63 - m));
        const size_t tok0 = (size_t)b * SEQ + seg * 512;
        const int di = wid >> 1, ei0 = 2 * (wid & 1), g = lane >> 4;
        f32x4 st[2] = {(f32x4){0.f, 0.f, 0.f, 0.f}, (f32x4){0.f, 0.f, 0.f, 0.f}};
        u32x4 kr = *(const u32x4*)(a.Kp + (tok0 + m) * 512 + hh * 64 + c8), vr = *(const u32x4*)(a.Vp + (tok0 + m) * 512 + hh * 64 + c8);
        for (int j = 0; j < 8; ++j) {
            LAS unsigned char* Kd = lds + (j & 1) * 2 * RT; LAS unsigned char* Vs = Kd + RT;
            *(LAS u32x4*)(Kd + (m * RLD + c8) * 2) = scale_bf16x8(kr, kdec);
            *(LAS u32x4*)(Vs + (m * RLD + c8) * 2) = vr;
            __syncthreads();
            if (j + 1 < 8) { kr = *(const u32x4*)(a.Kp + (tok0 + (j + 1) * 64 + m) * 512 + hh * 64 + c8); vr = *(const u32x4*)(a.Vp + (tok0 + (j + 1) * 64 + m) * 512 + hh * 64 + c8); }
            st[0] *= cdec; st[1] *= cdec;
#pragma unroll
            for (int ks = 0; ks < 2; ++ks) {
                const bf16x8 af = lds_tr8(Kd, 32 * ks, di, lane);
#pragma unroll
                for (int e = 0; e < 2; ++e) { const bf16x8 bfv = lds_tr8(Vs, 32 * ks, ei0 + e, lane); st[e] = __builtin_amdgcn_mfma_f32_16x16x32_bf16(af, bfv, st[e], 0, 0, 0); }
            }
        }
        float* so = a.sseg + (size_t)u * 4096;
#pragma unroll
        for (int e = 0; e < 2; ++e)
#pragma unroll
            for (int r = 0; r < 4; ++r) __hip_atomic_store(so + (16 * di + 4 * g + r) * 64 + 16 * (ei0 + e) + (lane & 15), st[e][r], __ATOMIC_RELAXED, __HIP_MEMORY_SCOPE_AGENT);
        asm volatile("s_waitcnt vmcnt(0)" ::: "memory");
        __syncthreads();
        if (tid == 0) __hip_atomic_store(a.segflag + 16 * u, 1u, __ATOMIC_RELAXED, __HIP_MEMORY_SCOPE_AGENT);
    }
}

__device__ __forceinline__ void phase_ret_out(const Args& a, LAS unsigned char* lds) {
    const int tid = threadIdx.x, lane = tid & 63, wid = __builtin_amdgcn_readfirstlane(tid >> 6), g = lane >> 4, l15 = lane & 15;
    const int u = blockIdx.x, b = u >> 5, hh = (u >> 2) & 7, seg = u & 3;
    const float l2g = __builtin_log2f(1.f - __builtin_amdgcn_exp2f(-5.f - (float)hh));
    const float cdec = __builtin_amdgcn_exp2f(l2g * 64.f);
    const int m = tid >> 3, c8 = (tid & 7) * 8;
    const float kdec = __builtin_amdgcn_exp2f(l2g * (float)(63 - m));
    const size_t tok0 = (size_t)b * SEQ + seg * 512;
    LAS unsigned char* Ps = lds + 8 * RT; LAS unsigned char* Stb = lds + 9 * RT;
    f32x4 st[4];
#pragma unroll
    for (int e = 0; e < 4; ++e) st[e] = (f32x4){0.f, 0.f, 0.f, 0.f};
    float bt[16];
#pragma unroll
    for (int e = 0; e < 4; ++e)
#pragma unroll
        for (int r = 0; r < 4; ++r) bt[4 * e + r] = a.beta_ret[hh * 64 + 16 * e + 4 * g + r];
    if (seg > 0) {
        if (wid == 0) {
            unsigned sp = 0;
            for (int s2 = 0; s2 < seg; ++s2) {
                while (__builtin_amdgcn_readfirstlane(__hip_atomic_load(a.segflag + 16 * (u - seg + s2), __ATOMIC_RELAXED, __HIP_MEMORY_SCOPE_AGENT)) == 0u) {
                    __builtin_amdgcn_s_sleep(1);
                    if (++sp > (1u << 20)) { if (lane == 0) atomicAdd(&a.bar[XB_TMO], 1u); break; }
                }
            }
            __builtin_amdgcn_fence(__ATOMIC_ACQUIRE, "agent");
            asm volatile("s_waitcnt vmcnt(0)" ::: "memory");
        }
        __syncthreads();
    }
    if (wid >= 4) {
        const int di = wid - 4;
        for (int s2 = 0; s2 < seg; ++s2) {
            const float wgt = __builtin_amdgcn_exp2f(l2g * 512.f * (float)(seg - 1 - s2));
            const float* sp = a.sseg + (size_t)(u - seg + s2) * 4096;
#pragma unroll
            for (int e = 0; e < 4; ++e)
#pragma unroll
                for (int r = 0; r < 4; ++r) st[e][r] += wgt * sp[(16 * di + 4 * g + r) * 64 + 16 * e + l15];
        }
#pragma unroll
        for (int e = 0; e < 4; ++e) { u32x2 w; w.x = cvt_pk_bf16(st[e][0], st[e][1]); w.y = cvt_pk_bf16(st[e][2], st[e][3]); *(LAS u32x2*)(Stb + ((16 * e + l15) * RLD + 16 * di + 4 * g) * 2) = w; }
    }
    const bf16_t* qp = a.Qp + (tok0 + m) * 512 + hh * 64 + c8; const bf16_t* kp = a.Kp + (tok0 + m) * 512 + hh * 64 + c8; const bf16_t* vp = a.Vp + (tok0 + m) * 512 + hh * 64 + c8;
    u32x4 qr = *(const u32x4*)qp, kr = *(const u32x4*)kp, vr = *(const u32x4*)vp;
    for (int j = 0; j < 8; ++j) {
        LAS unsigned char* Qs = lds + (j & 1) * 4 * RT; LAS unsigned char* Ks = Qs + RT; LAS unsigned char* Kd = Qs + 2 * RT; LAS unsigned char* Vs = Qs + 3 * RT;
        LAS unsigned char* Stc = Stb + (j & 1) * RT; LAS unsigned char* Stn = Stb + ((j + 1) & 1) * RT;
        *(LAS u32x4*)(Qs + (m * RLD + c8) * 2) = qr; *(LAS u32x4*)(Ks + (m * RLD + c8) * 2) = kr;
        *(LAS u32x4*)(Kd + (m * RLD + c8) * 2) = scale_bf16x8(kr, kdec); *(LAS u32x4*)(Vs + (m * RLD + c8) * 2) = vr;
        __syncthreads();
        if (j + 1 < 8) { qr = *(const u32x4*)(qp + (size_t)(j + 1) * 64 * 512); kr = *(const u32x4*)(kp + (size_t)(j + 1) * 64 * 512); vr = *(const u32x4*)(vp + (size_t)(j + 1) * 64 * 512); }
        {
            const int mi = wid >> 1, ci0 = 2 * (wid & 1);
            f32x4 xs[2] = {(f32x4){0.f, 0.f, 0.f, 0.f}, (f32x4){0.f, 0.f, 0.f, 0.f}};
#pragma unroll
            for (int ks = 0; ks < 2; ++ks) {
                const bf16x8 af = lds_row8(Ks, 16 * mi + l15, 32 * ks + 8 * g);
#pragma unroll
                for (int c = 0; c < 2; ++c) { const bf16x8 bfv = lds_row8(Qs, 16 * (ci0 + c) + l15, 32 * ks + 8 * g); xs[c] = __builtin_amdgcn_mfma_f32_16x16x32_bf16(af, bfv, xs[c], 0, 0, 0); }
            }
#pragma unroll
            for (int c = 0; c < 2; ++c) {
                const int cc = 16 * (ci0 + c) + l15, mm = 16 * mi + 4 * g;
                float pv[4];
#pragma unroll
                for (int r = 0; r < 4; ++r) { const int d = cc - (mm + r); pv[r] = xs[c][r] * __builtin_amdgcn_exp2f(l2g * (float)(d < 0 ? -d : d)); }
                u32x2 w; w.x = cvt_pk_bf16(pv[0], pv[1]); w.y = cvt_pk_bf16(pv[2], pv[3]);
                *(LAS u32x2*)(Ps + (cc * RLD + mm) * 2) = w;
            }
        }
        __syncthreads();
        if (wid < 4) {
            const int cc = 16 * wid + l15; const size_t tok = tok0 + (size_t)j * 64 + cc;
            u32x2 gw[4];
#pragma unroll
            for (int e = 0; e < 4; ++e) gw[e] = *(const u32x2*)(a.Gp + tok * 512 + hh * 64 + 16 * e + 4 * g);
            f32x4 yi[4], ys[4];
#pragma unroll
            for (int e = 0; e < 4; ++e) { yi[e] = (f32x4){0.f, 0.f, 0.f, 0.f}; ys[e] = (f32x4){0.f, 0.f, 0.f, 0.f}; }
#pragma unroll
            for (int ks = 0; ks < 2; ++ks) {
                const bf16x8 pb = lds_row8(Ps, cc, 32 * ks + 8 * g), qb = lds_row8(Qs, cc, 32 * ks + 8 * g);
#pragma unroll
                for (int e = 0; e < 4; ++e) {
                    const bf16x8 va = lds_tr8(Vs, 32 * ks, e, lane);
                    yi[e] = __builtin_amdgcn_mfma_f32_16x16x32_bf16(va, pb, yi[e], 0, 0, 0);
                    const bf16x8 sa = lds_row8(Stc, 16 * e + l15, 32 * ks + 8 * g);
                    ys[e] = __builtin_amdgcn_mfma_f32_16x16x32_bf16(sa, qb, ys[e], 0, 0, 0);
                }
            }
            const float qdec = __builtin_amdgcn_exp2f(l2g * (float)(cc + 1));
            float sum = 0.f;
#pragma unroll
            for (int e = 0; e < 4; ++e) { yi[e] += ys[e] * qdec; sum += (yi[e][0] + yi[e][1]) + (yi[e][2] + yi[e][3]); }
            sum += __shfl_xor(sum, 16); sum += __shfl_xor(sum, 32);
            const float mu = sum * (1.f / 64.f); float vq = 0.f;
#pragma unroll
            for (int e = 0; e < 4; ++e) { const f32x4 d = yi[e] - mu; vq += (d[0] * d[0] + d[1] * d[1]) + (d[2] * d[2] + d[3] * d[3]); }
            vq += __shfl_xor(vq, 16); vq += __shfl_xor(vq, 32);
            const float rs = __builtin_amdgcn_rsqf(vq * (1.f / 64.f) + 1e-5f);
#pragma unroll
            for (int e = 0; e < 4; ++e) {
                const float g0 = bf_lo(gw[e].x), g1 = bf_hi(gw[e].x), g2 = bf_lo(gw[e].y), g3 = bf_hi(gw[e].y);
                u32x2 w; w.x = cvt_pk_bf16((yi[e][0] - mu) * rs * g0 * bt[4 * e], (yi[e][1] - mu) * rs * g1 * bt[4 * e + 1]);
                w.y = cvt_pk_bf16((yi[e][2] - mu) * rs * g2 * bt[4 * e + 2], (yi[e][3] - mu) * rs * g3 * bt[4 * e + 3]);
                *(u32x2*)(a.Y + tok * DM + hh * 64 + 16 * e + 4 * g) = w;
            }
        } else {
            const int di = wid - 4;
#pragma unroll
            for (int e = 0; e < 4; ++e) st[e] *= cdec;
#pragma unroll
            for (int ks = 0; ks < 2; ++ks) {
                const bf16x8 af = lds_tr8(Kd, 32 * ks, di, lane);
#pragma unroll
                for (int e = 0; e < 4; ++e) { const bf16x8 bfv = lds_tr8(Vs, 32 * ks, e, lane); st[e] = __builtin_amdgcn_mfma_f32_16x16x32_bf16(af, bfv, st[e], 0, 0, 0); }
            }
#pragma unroll
            for (int e = 0; e < 4; ++e) { u32x2 w; w.x = cvt_pk_bf16(st[e][0], st[e][1]); w.y = cvt_pk_bf16(st[e][2], st[e][3]); *(LAS u32x2*)(Stn + ((16 * e + l15) * RLD + 16 * di + 4 * g) * 2) = w; }
        }
    }
}

__device__ __forceinline__ void phase_norm2_router(const Args& a, LAS unsigned char* lds) {
    const int tid = threadIdx.x, lane = tid & 63, wid = __builtin_amdgcn_readfirstlane(tid >> 6), g = lane >> 4, l15 = lane & 15, b = blockIdx.x >> 5;
    constexpr int ALD = 1032;
    LAS unsigned char* At = lds;
    LAS float* part = (LAS float*)(lds + 66048);
    LAS float* logit = (LAS float*)(lds + 115200);
    LAS int* hist = (LAS int*)(lds + 121344);
    LAS int* hbase = (LAS int*)(lds + 121344 + 128);
    LAS int* selE = (LAS int*)(lds + 121344 + 256);
    LAS int* selS = (LAS int*)(lds + 121344 + 256 + 512);
    if (tid < 32) hist[tid] = 0;
    float Am[16], Bm[16];
    load_mod_consts(a.g_ffn, a.mod + (size_t)b * MODW, 3 * DM, 4 * DM, lane, Am, Bm);
    bf16x8 Bf[3][4];
#pragma unroll
    for (int nt = 0; nt < 3; ++nt)
#pragma unroll
        for (int ks = 0; ks < 4; ++ks) Bf[nt][ks] = *(const bf16x8*)(a.WrT + (size_t)(16 * nt + l15) * DM + 128 * wid + 32 * ks + 8 * g);
    const int row_base = blockIdx.x * 64;
    for (int it = 0; it < 2; ++it) {
#pragma unroll 1
        for (int q = 0; q < 4; ++q) {
            const int lr = 4 * wid + q, row = row_base + 32 * it + lr;
            const bf16_t* xr = a.x1b + (size_t)row * DM + 4 * lane;
            f32x4 v[4]; float ss = 0.f;
#pragma unroll
            for (int i = 0; i < 4; ++i) { const u32x2 xw = *(const u32x2*)(xr + 256 * i); v[i] = (f32x4){bf_lo(xw.x), bf_hi(xw.x), bf_lo(xw.y), bf_hi(xw.y)}; ss += v[i][0] * v[i][0] + v[i][1] * v[i][1] + v[i][2] * v[i][2] + v[i][3] * v[i][3]; }
            ss = wave_sum(ss);
            const float rs = __builtin_amdgcn_rsqf(ss * (1.f / DM) + 1e-6f);
            unsigned char* hr = a.h2q + (size_t)row * DM + 4 * lane;
#pragma unroll
            for (int i = 0; i < 4; ++i) {
                const float h0 = v[i][0] * rs * Am[4 * i] + Bm[4 * i], h1 = v[i][1] * rs * Am[4 * i + 1] + Bm[4 * i + 1], h2v = v[i][2] * rs * Am[4 * i + 2] + Bm[4 * i + 2], h3 = v[i][3] * rs * Am[4 * i + 3] + Bm[4 * i + 3];
                u32x2 w; w.x = cvt_pk_bf16(h0, h1); w.y = cvt_pk_bf16(h2v, h3);
                *(LAS u32x2*)(At + (lr * ALD + 256 * i + 4 * lane) * 2) = w;
                int pk = __builtin_amdgcn_cvt_pk_fp8_f32(h0, h1, 0, false); pk = __builtin_amdgcn_cvt_pk_fp8_f32(h2v, h3, pk, true);
                *(int*)(hr + 256 * i) = pk;
            }
        }
        __syncthreads();
        {
            f32x4 pa[2][3];
#pragma unroll
            for (int mt = 0; mt < 2; ++mt)
#pragma unroll
                for (int nt = 0; nt < 3; ++nt) pa[mt][nt] = (f32x4){0.f, 0.f, 0.f, 0.f};
#pragma unroll
            for (int ks = 0; ks < 4; ++ks)
#pragma unroll
                for (int mt = 0; mt < 2; ++mt) {
                    const bf16x8 af = *(const LAS bf16x8*)(At + ((16 * mt + l15) * ALD + 128 * wid + 32 * ks + 8 * g) * 2);
#pragma unroll
                    for (int nt = 0; nt < 3; ++nt) pa[mt][nt] = __builtin_amdgcn_mfma_f32_16x16x32_bf16(af, Bf[nt][ks], pa[mt][nt], 0, 0, 0);
                }
#pragma unroll
            for (int mt = 0; mt < 2; ++mt)
#pragma unroll
                for (int nt = 0; nt < 3; ++nt)
#pragma unroll
                    for (int r = 0; r < 4; ++r) part[(wid * 32 + 16 * mt + 4 * g + r) * 48 + 16 * nt + l15] = pa[mt][nt][r];
        }
        __syncthreads();
        for (int idx = tid; idx < 32 * 48; idx += NTHR) {
            const int col = idx % 48; float s = 0.f;
#pragma unroll
            for (int w = 0; w < 8; ++w) s += part[w * 1536 + idx];
            if (col < 4) s += a.rgb[col]; else if (col < 36) s += a.reb[col - 4];
            logit[idx] = s;
        }
        __syncthreads();
        if (tid < 32) {
            const LAS float* lg = logit + tid * 48;
            int gi = 0; float gm = lg[0];
#pragma unroll
            for (int j = 1; j < 4; ++j) { const float v = lg[j]; if (v > gm) { gm = v; gi = j; } }
            float gs = 0.f;
#pragma unroll
            for (int j = 0; j < 4; ++j) gs += __expf(lg[j] - gm);
            const float gtop = 1.f / gs;
            const LAS float* el = lg + 4 + gi * 8;
            int i1 = 0; float l1 = el[0];
#pragma unroll
            for (int j = 1; j < 8; ++j) { const float v = el[j]; if (v > l1) { l1 = v; i1 = j; } }
            int i2 = 0; float l2 = -3.0e38f;
#pragma unroll
            for (int j = 0; j < 8; ++j) { const float v = el[j]; if (j != i1 && v > l2) { l2 = v; i2 = j; } }
            const float ex = __expf(l2 - l1);
            const float w1 = gtop / (1.f + ex), w2 = gtop * ex / (1.f + ex);
            const int e0 = gi * 8 + i1, e1 = gi * 8 + i2, tl = 32 * it + tid, t = row_base + tl;
            selE[2 * tl] = e0; selS[2 * tl] = atomicAdd((int*)&hist[e0], 1);
            selE[2 * tl + 1] = e1; selS[2 * tl + 1] = atomicAdd((int*)&hist[e1], 1);
            a.pw[2 * t] = w1; a.pw[2 * t + 1] = w2;
        }
    }
    __syncthreads();
    if (tid < 32) { const int n = hist[tid]; hbase[tid] = n ? atomicAdd(&a.counts[tid], n) : 0; }
    __syncthreads();
    if (tid < 128) { const int e = selE[tid]; a.lists[e * LCAP + hbase[e] + selS[tid]] = 2 * row_base + tid; }
}

__device__ __forceinline__ void phase_final(const Args& a, float* dst) {
    const int tid = threadIdx.x, lane = tid & 63, wid = tid >> 6, b = blockIdx.x >> 5;
    float gf[16], gn[16];
#pragma unroll
    for (int i = 0; i < 4; ++i) {
        const f32x4 g1 = *(const f32x4*)(a.mod + (size_t)b * MODW + 5 * DM + 256 * i + 4 * lane), g2 = *(const f32x4*)(a.g_fin + 256 * i + 4 * lane);
#pragma unroll
        for (int j = 0; j < 4; ++j) { gf[4 * i + j] = g1[j]; gn[4 * i + j] = g2[j]; }
    }
#pragma unroll 2
    for (int q = 0; q < 8; ++q) {
        const int row = blockIdx.x * 64 + wid * 8 + q;
        const bf16_t* xr = a.x1b + (size_t)row * DM + 4 * lane;
        const bf16_t* o0 = a.opair + (size_t)(2 * row) * DM + 4 * lane; const bf16_t* o1 = o0 + DM;
        f32x4 v[4]; float ss = 0.f;
#pragma unroll
        for (int i = 0; i < 4; ++i) {
            const u32x2 xw = *(const u32x2*)(xr + 256 * i); const f32x4 xv = (f32x4){bf_lo(xw.x), bf_hi(xw.x), bf_lo(xw.y), bf_hi(xw.y)}; const u32x2 pa = *(const u32x2*)(o0 + 256 * i), pb = *(const u32x2*)(o1 + 256 * i);
            v[i][0] = xv[0] + gf[4 * i] * (bf_lo(pa.x) + bf_lo(pb.x)); v[i][1] = xv[1] + gf[4 * i + 1] * (bf_hi(pa.x) + bf_hi(pb.x));
            v[i][2] = xv[2] + gf[4 * i + 2] * (bf_lo(pa.y) + bf_lo(pb.y)); v[i][3] = xv[3] + gf[4 * i + 3] * (bf_hi(pa.y) + bf_hi(pb.y));
            ss += v[i][0] * v[i][0] + v[i][1] * v[i][1] + v[i][2] * v[i][2] + v[i][3] * v[i][3];
        }
        ss = wave_sum(ss);
        const float rs = __builtin_amdgcn_rsqf(ss * (1.f / DM) + 1e-6f);
#pragma unroll
        for (int i = 0; i < 4; ++i) {
            f32x4 o; o[0] = v[i][0] * rs * gn[4 * i]; o[1] = v[i][1] * rs * gn[4 * i + 1]; o[2] = v[i][2] * rs * gn[4 * i + 2]; o[3] = v[i][3] * rs * gn[4 * i + 3];
            *(f32x4*)(dst + (size_t)row * DM + 4 * lane + 256 * i) = o;
        }
    }
}

#ifndef PROBE_DUP
#define PROBE_DUP 0
#endif
#define RUN(p) (a.p0 <= (p) && (p) < a.p1)
#define REP(p, ...) do { __VA_ARGS__ if constexpr (((PROBE_DUP) >> (p)) & 1) { __VA_ARGS__ } } while (0)
#define SYNC(p) do { if (a.p0 <= (p) && (p) + 1 < a.p1) { xcd_barrier(bar); if constexpr ((PROBE_DUP >> 16) & 1) xcd_barrier(bar); } } while (0)
__global__ void __launch_bounds__(NTHR, 2) mk_fwd(Args a) {
    extern __shared__ __attribute__((aligned(16))) unsigned char shm[];
    LAS unsigned char* lds = (LAS unsigned char*)shm;
    volatile LAS unsigned* xbw = (volatile LAS unsigned*)(lds + LDS_MISC);
    if (threadIdx.x < 4) xbw[threadIdx.x] = 0u;
    __syncthreads();
    XcdBarrier bar; bar.bar = a.bar; bar.x = 0; bar.st = xbw;
    if (a.p1 - a.p0 > 1) bar = xcd_barrier_post(a.bar, xbw);
    LAS int* mpre = (LAS int*)(lds + LDS_MISC + 64); LAS int* mcnt = (LAS int*)(lds + LDS_MISC + 64 + 256);

    if (RUN(0)) REP(0, { phase_prep(a, lds); __syncthreads(); });
    SYNC(0);
    if (RUN(1)) REP(1, phase_norm1(a););
    SYNC(1);
    if (RUN(2)) REP(2, { if (blockIdx.x >= NGEMM) { convert_tiles<1>(a, (LAS float*)(lds + (threadIdx.x >> 6) * 16640), W1_PRE + (blockIdx.x - NGEMM) * 8 + (threadIdx.x >> 6), 8192, (NWG - NGEMM) * 8, threadIdx.x & 63); } else {
        ProbInProj P; P.K = DM; P.S.init(NTOK, INC, NGEMM, blockIdx.x); P.A = (const char*)a.h; P.Bt = (const char*)a.WinT; P.pos = a.pos;
        P.Qp = a.Qp; P.Kp = a.Kp; P.Vp = a.Vp; P.Gp = a.Gp; P.Bp = a.Bp; P.Up = a.Up; pg8::gemm_phase(lds, P); } });
    SYNC(2);
    if (RUN(3)) REP(3, { phase_conv_seg(a, lds); __syncthreads(); });
    __syncthreads();
    if (RUN(4)) REP(4, { phase_ret_out(a, lds); __syncthreads(); });
    SYNC(4);
    if (RUN(5)) REP(5, { ProbOutProj P; P.K = DM; P.S.init(NTOK, DM, gridDim.x, blockIdx.x); P.A = (const char*)a.Y; P.Bt = (const char*)a.WoutT; P.x = a.x; P.mod = a.mod; P.x1 = a.x1b; pg8::gemm_phase(lds, P); });
    SYNC(5);
    if constexpr ((PROBE_DUP >> 6) & 1) { Args a2 = a; a2.counts = a.counts + 32; phase_norm2_router(a2, lds); __syncthreads(); }
    if (RUN(6)) phase_norm2_router(a, lds);
    SYNC(6);
    if (RUN(7)) REP(7, { if (blockIdx.x >= NGEMM) { convert_tiles<2>(a, (LAS float*)(lds + (threadIdx.x >> 6) * 16640), W2_PRE + (blockIdx.x - NGEMM) * 8 + (threadIdx.x >> 6), 4096, (NWG - NGEMM) * 8, threadIdx.x & 63); } else {
        __syncthreads(); moe_tables(a.counts, mpre, mcnt);
        ProbMoe1 P; P.K = DM / 2; P.S.pre = mpre; P.S.cnts = mcnt; P.S.G = NGEMM; P.S.c = blockIdx.x; P.S.NT = 4; P.A = (const char*)a.h2q; P.Bt = (const char*)a.W1Q; P.lists = a.lists; P.pw = a.pw; P.hid = a.hid; pg8::gemm_phase_f8(lds, P); } });
    SYNC(7);
    if (RUN(8)) REP(8, { __syncthreads(); moe_tables(a.counts, mpre, mcnt);
        ProbMoe2 P; P.K = DE / 2; P.S.pre = mpre; P.S.cnts = mcnt; P.S.G = gridDim.x; P.S.c = blockIdx.x; P.S.NT = 4; P.A = (const char*)a.hidq; P.Bt = (const char*)a.W2Q; P.lists = a.lists; P.opair = a.opair; pg8::gemm_phase_f8(lds, P); });
    SYNC(8);
    if constexpr ((PROBE_DUP >> 9) & 1) { phase_final(a, (float*)a.W1T); }
    if (RUN(9)) phase_final(a, a.out);
}

extern "C" void kernel_launch(void* const* d_in, const int* in_sizes, int n_in, void* d_out, int out_size, void* d_ws, size_t ws_size, hipStream_t stream) {
    Args a; memset(&a, 0, sizeof(a));
    a.x = (const float*)d_in[0]; a.c = (const float*)d_in[1]; a.pos = (const int*)d_in[2]; a.ada_w = (const float*)d_in[3]; a.ada_b = (const float*)d_in[4];
    a.g_mix = (const float*)d_in[5]; a.g_ffn = (const float*)d_in[6]; a.w_in = (const float*)d_in[7]; a.conv_w = (const float*)d_in[8]; a.conv_b = (const float*)d_in[9];
    a.beta_ret = (const float*)d_in[10]; a.beta_conv = (const float*)d_in[11]; a.w_out = (const float*)d_in[12]; a.rgw = (const float*)d_in[13]; a.rgb = (const float*)d_in[14];
    a.rew = (const float*)d_in[15]; a.reb = (const float*)d_in[16]; a.ewg = (const float*)d_in[17]; a.ewu = (const float*)d_in[18]; a.ewd = (const float*)d_in[19]; a.g_fin = (const float*)d_in[20];
    a.out = (float*)d_out;
    char* ws = (char*)d_ws; size_t off = 0;
    auto carve = [&](size_t bytes) { void* p = ws + off; off += (bytes + 255) & ~(size_t)255; return p; };
    a.bar = (unsigned*)carve(XCD_BAR_WORDS * 4);
    a.counts = (int*)carve(256);
    a.segflag = (unsigned*)carve(256 * 64);
    const size_t zero_bytes = off;
    a.mod = (float*)carve((size_t)NB * MODW * 4);
    a.lists = (int*)carve((size_t)NE * LCAP * 4);
    a.pw = (float*)carve((size_t)2 * NTOK * 4);
    a.sseg = (float*)carve((size_t)256 * 4096 * 4);
    a.WrT = (bf16_t*)carve((size_t)48 * DM * 2);
    a.WinT = (bf16_t*)carve((size_t)INC * DM * 2);
    a.WoutT = (bf16_t*)carve((size_t)DM * DM * 2);
    a.W1T = (bf16_t*)carve((size_t)NE * 1024 * DM * 2);
    a.W2T = (bf16_t*)carve((size_t)NE * 1024 * DE * 2);
    a.h = (bf16_t*)carve((size_t)NTOK * DM * 2);
    bf16_t* big = (bf16_t*)carve((size_t)NTOK * 512 * 2 * 6);
    a.Y = (bf16_t*)carve((size_t)NTOK * DM * 2);
    if (off > ws_size) return;
    a.Qp = big; a.Kp = big + (size_t)NTOK * 512; a.Vp = big + (size_t)NTOK * 512 * 2; a.Gp = big + (size_t)NTOK * 512 * 3; a.Bp = big + (size_t)NTOK * 512 * 4; a.Up = big + (size_t)NTOK * 512 * 5;
    a.h2 = a.h; a.hid = a.Y; a.opair = big; a.h2q = (unsigned char*)a.h; a.hidq = (unsigned char*)a.Y; a.W1Q = (unsigned char*)a.W1T; a.W2Q = (unsigned char*)a.W2T; a.x1b = big + (size_t)NTOK * 512 * 4;

    static bool attr = false;
    if (!attr) { (void)hipFuncSetAttribute((const void*)mk_fwd, hipFuncAttributeMaxDynamicSharedMemorySize, LDS_BYTES); attr = true; }
    (void)hipMemsetAsync(d_ws, 0, zero_bytes, stream);
#if MK_LAUNCHES == 1
    a.p0 = 0; a.p1 = 10;
    hipLaunchKernelGGL(mk_fwd, dim3(NWG), dim3(NTHR), LDS_BYTES, stream, a);
#else
    for (int p = 0; p < 10; ++p) { a.p0 = p; a.p1 = p + 1; hipLaunchKernelGGL(mk_fwd, dim3(NWG), dim3(NTHR), LDS_BYTES, stream, a); }
#endif
}
```

```cpp
#include <hip/hip_runtime.h>
#include <stdint.h>
#include <string.h>

#ifndef MK_LAUNCHES
#define MK_LAUNCHES 1
#endif

#define LAS __attribute__((address_space(3)))
typedef unsigned short bf16_t;
typedef short bf16x8 __attribute__((ext_vector_type(8)));
typedef short s16x4 __attribute__((ext_vector_type(4)));
typedef float f32x4 __attribute__((ext_vector_type(4)));
typedef unsigned u32x4 __attribute__((ext_vector_type(4)));
typedef unsigned u32x2 __attribute__((ext_vector_type(2)));
typedef int v4i_t __attribute__((ext_vector_type(4)));
typedef int v8i_t __attribute__((ext_vector_type(8)));

constexpr int DM = 1024, NB = 8, SEQ = 2048, NTOK = NB * SEQ, INC = 3584, NH = 8, NE = 32, DE = 512, MODW = 6144, LCAP = 16384;
constexpr int NWG = 256, NTHR = 512;
constexpr int NGEMM = 224;
#ifndef W2_PRE
#define W2_PRE 0
#endif
#ifndef W1_PRE
#define W1_PRE 4096
#endif
constexpr int LDS_BYTES = 147456;
constexpr int LDS_MISC = 146432;

#define XB_TMO      128
#define XB_XCNT(j)  (256  + 64 * (j))
#define XB_XSUB(j)  (1280 + 64 * (j))
#define XB_XGEN(j)  (2304 + 64 * (j))
#define XB_TOP      3328
#define XB_TOPGEN   3392
#define XCD_BAR_WORDS 3456
#define XB_SPIN_CAP (1u << 18)
__device__ __forceinline__ unsigned xb_ld(unsigned* p)              { return __hip_atomic_load(p, __ATOMIC_RELAXED, __HIP_MEMORY_SCOPE_AGENT); }
__device__ __forceinline__ unsigned xb_add(unsigned* p, unsigned v) { return __hip_atomic_fetch_add(p, v, __ATOMIC_RELAXED, __HIP_MEMORY_SCOPE_AGENT); }
__device__ __forceinline__ unsigned xb_xcc_id() { return (unsigned)__builtin_amdgcn_s_getreg((3 << 11) | 20) & 0xFu; }
#define XB_SPIN(cond, bar) do { unsigned _sp = 0; while (cond) { __builtin_amdgcn_s_sleep(1); \
    if ((++_sp & 255u) == 0u) { if (xb_ld(&(bar)[XB_TMO])) break; if (_sp > XB_SPIN_CAP) { atomicAdd(&(bar)[XB_TMO], 1u); break; } } } } while (0)
struct XcdBarrier { unsigned* bar; unsigned x; volatile LAS unsigned* st; };
__device__ __forceinline__ XcdBarrier xcd_barrier_post(unsigned* bar, volatile LAS unsigned* st) {
    XcdBarrier b; b.bar = bar; b.x = xb_xcc_id(); b.st = st;
    if (threadIdx.x == 0) (void)xb_add(&bar[XB_XCNT(b.x)], 1u);
    return b;
}
__device__ __forceinline__ void xcd_barrier_complete(unsigned* bar, unsigned x, unsigned& nloc, unsigned& nx) {
    const unsigned G = gridDim.x * gridDim.y * gridDim.z;
    unsigned sum, cnt, mine, sp = 0u;
    for (;;) {
        sum = 0u; cnt = 0u; mine = 0u;
#pragma unroll
        for (unsigned j = 0; j < 16; ++j) { const unsigned c = xb_ld(&bar[XB_XCNT(j)]); sum += c; cnt += (c > 0u) ? 1u : 0u; mine = (j == x) ? c : mine; }
        if (sum == G) break;
        __builtin_amdgcn_s_sleep(1);
        if ((++sp & 255u) == 0u) { if (xb_ld(&bar[XB_TMO])) break; if (sp > XB_SPIN_CAP) { atomicAdd(&bar[XB_TMO], 1u); break; } }
    }
    nloc = mine > 0u ? mine : 1u; nx = cnt > 0u ? cnt : 1u;
}
__device__ __forceinline__ void xcd_barrier(const XcdBarrier& b) {
    asm volatile("s_waitcnt vmcnt(0)" ::: "memory");
    __syncthreads();
    if (threadIdx.x == 0) {
        unsigned* bar = b.bar;
        __builtin_amdgcn_s_waitcnt(0);
        unsigned nloc = b.st[0], nx = b.st[1];
        if (nloc == 0u) { xcd_barrier_complete(bar, b.x, nloc, nx); b.st[0] = nloc; b.st[1] = nx; }
        const unsigned old = xb_add(&bar[XB_XSUB(b.x)], 1u);
        const unsigned gen = old / nloc;
        if (old + 1u == (gen + 1u) * nloc) {
            __builtin_amdgcn_fence(__ATOMIC_RELEASE, "agent");
            asm volatile("s_waitcnt vmcnt(0)" ::: "memory");
            const unsigned og = xb_add(&bar[XB_TOP], 1u);
            const unsigned tg = og / nx;
            if (og + 1u == (tg + 1u) * nx) xb_add(&bar[XB_TOPGEN], 1u);
            else XB_SPIN(xb_ld(&bar[XB_TOPGEN]) == tg, bar);
            __builtin_amdgcn_fence(__ATOMIC_ACQUIRE, "agent");
            xb_add(&bar[XB_XGEN(b.x)], 1u);
            asm volatile("s_waitcnt vmcnt(0)" ::: "memory");
        } else {
            XB_SPIN(xb_ld(&bar[XB_XGEN(b.x)]) == gen, bar);
            __builtin_amdgcn_fence(__ATOMIC_ACQUIRE, "agent");
            asm volatile("s_waitcnt vmcnt(0)" ::: "memory");
        }
    }
    __syncthreads();
}

typedef __bf16 bf16x2_t __attribute__((ext_vector_type(2)));
typedef float f32x2_t __attribute__((ext_vector_type(2)));
__device__ __forceinline__ unsigned cvt_pk_bf16(float lo, float hi) { const f32x2_t f = {lo, hi}; return __builtin_bit_cast(unsigned, __builtin_convertvector(f, bf16x2_t)); }
__device__ __forceinline__ float bf_lo(unsigned w) { return __uint_as_float(w << 16); }
__device__ __forceinline__ float bf_hi(unsigned w) { return __uint_as_float(w & 0xffff0000u); }
__device__ __forceinline__ float fast_silu(float x) { return x * __builtin_amdgcn_rcpf(1.f + __builtin_amdgcn_exp2f(-1.44269504089f * x)); }
__device__ __forceinline__ float wave_sum(float v) {
#pragma unroll
    for (int o = 32; o >= 1; o >>= 1) v += __shfl_xor(v, o);
    return v;
}

struct Args {
    const float *x, *c; const int* pos;
    const float *ada_w, *ada_b, *g_mix, *g_ffn, *w_in, *conv_w, *conv_b, *beta_ret, *beta_conv, *w_out, *rgw, *rgb, *rew, *reb, *ewg, *ewu, *ewd, *g_fin;
    float* out;
    unsigned* bar; int* counts; unsigned* segflag; float* mod; int* lists; float* pw; float* sseg;
    bf16_t *WinT, *WoutT, *W1T, *W2T, *WrT;
    bf16_t *h, *Qp, *Kp, *Vp, *Gp, *Bp, *Up, *Y, *h2, *hid, *opair, *x1b;
    unsigned char *h2q, *hidq, *W1Q, *W2Q;
    int p0, p1;
};

namespace pg8 {
constexpr int BM = 256, BK = 64, HALF = 128, HTB = HALF * BK * 2, STAGE_BYTES = 8 * HTB;
__device__ __forceinline__ int lds_byte(int r, int c) { const int st = (r >> 4) * 2 + (c >> 5), rr = r & 15, cc = c & 31, ob = rr * 64 + cc * 2; return st * 1024 + (ob ^ (((ob >> 9) & 1) << 5)); }
__device__ __forceinline__ void stage_rc(int b, int& R, int& C) { const int st = b / 1024, sb = b % 1024, swz = sb ^ (((sb >> 9) & 1) << 5); R = (st >> 1) * 16 + swz / 64; C = (st & 1) * 32 + (swz % 64) / 2; }
__device__ __forceinline__ int perm32(int rho) { const int n = rho >> 4, i = rho & 15; return 8 * (i >> 2) + 4 * n + (i & 3); }

struct Unit { int pm, pn, e, cnt; };

template <class P>
__device__ __forceinline__ void gemm_phase(LAS unsigned char* lds, const P& prob) {
    const int tid = threadIdx.x, wid = __builtin_amdgcn_readfirstlane(tid >> 6), lane = tid & 63, wr = wid >> 2, wc = wid & 3, fr = lane & 15, fq = lane >> 4;
    const int K = prob.K, nt = K / BK;
    int RA[2]; unsigned CA2[2], voffB[2];
#pragma unroll
    for (int i = 0; i < 2; ++i) { int R, C; stage_rc(tid * 16 + i * 8192, R, C); const int Rb = P::PERM ? ((R & ~31) + perm32(R & 31)) : R;
        RA[i] = R; CA2[i] = (unsigned)C * 2u; voffB[i] = (unsigned)(Rb * K + C) * 2u; }
    const unsigned kstep = (unsigned)(BK * 2);
    const size_t hstep = (size_t)HALF * K * 2;
    const unsigned ldsw = (unsigned)wid * 1024u;
    const int aoff = lds_byte(wr * 64 + fr, fq * 8), boff = lds_byte(wc * 32 + fr, fq * 8);
#define PG8_SA(b, h) (((b) * 2 + (h)) * HTB)
#define PG8_SB(b, h) ((4 + (b) * 2 + (h)) * HTB)
#define PG8_STAGE_B(bufoff, gbase) do { _Pragma("unroll") for (int _i = 0; _i < 2; ++_i) \
        __builtin_amdgcn_global_load_lds((const unsigned*)((const char*)(gbase) + voffB[_i]), (LAS unsigned*)(lds + (bufoff) + ldsw + _i * 8192), 16, 0, 0); } while (0)
#define PG8_STAGE_A(bufoff, offh, kb) do { _Pragma("unroll") for (int _i = 0; _i < 2; ++_i) \
        __builtin_amdgcn_global_load_lds((const unsigned*)(Ab + (size_t)((offh)[_i] + (kb))), (LAS unsigned*)(lds + (bufoff) + ldsw + _i * 8192), 16, 0, 0); } while (0)
#define PG8_LDA(dst, b, h) do { _Pragma("unroll") for (int m = 0; m < 4; ++m) _Pragma("unroll") for (int k = 0; k < 2; ++k) dst[m][k] = *(const LAS bf16x8*)(lds + PG8_SA(b, h) + aoff + m * 2048 + k * 1024); } while (0)
#define PG8_LDB(dst, b, h) do { _Pragma("unroll") for (int n = 0; n < 2; ++n) _Pragma("unroll") for (int k = 0; k < 2; ++k) dst[n][k] = *(const LAS bf16x8*)(lds + PG8_SB(b, h) + boff + n * 2048 + k * 1024); } while (0)
#define PG8_MMA(ai, bj, At, Bt) do { __builtin_amdgcn_s_setprio(1); _Pragma("unroll") for (int m = 0; m < 4; ++m) _Pragma("unroll") for (int n = 0; n < 2; ++n) _Pragma("unroll") for (int k = 0; k < 2; ++k) \
        acc[ai][bj][m][n] = __builtin_amdgcn_mfma_f32_16x16x32_bf16(Bt[n][k], At[m][k], acc[ai][bj][m][n], 0, 0, 0); __builtin_amdgcn_s_setprio(0); } while (0)
#define PG8_WAIT_V(n) asm volatile("s_waitcnt vmcnt(" #n ")" ::: "memory")
#define PG8_WAIT_L(n) asm volatile("s_waitcnt lgkmcnt(" #n ")" ::: "memory")
#define PG8_BAR __builtin_amdgcn_s_barrier()
#define PG8_SCHED __builtin_amdgcn_sched_barrier(0)
    Unit cur, nxt; int ui = 0;
    if (!prob.next(0, cur)) return;
    f32x4 acc[2][2][4][2];
#pragma unroll
    for (int a = 0; a < 2; ++a)
#pragma unroll
        for (int b = 0; b < 2; ++b)
#pragma unroll
            for (int m = 0; m < 4; ++m)
#pragma unroll
                for (int n = 0; n < 2; ++n) acc[a][b][m][n] = (f32x4){0.f, 0.f, 0.f, 0.f};
    bf16x8 At[4][2], B0[2][2], B1[2][2];
    const char* Ab = prob.a_base();
    unsigned cO0[2], cO1[2], nO0[2], nO1[2];
#pragma unroll
    for (int i = 0; i < 2; ++i) { cO0[i] = prob.a_row(cur, RA[i]) + CA2[i]; cO1[i] = prob.a_row(cur, HALF + RA[i]) + CA2[i]; }
    const char* cB = prob.b_tile(cur);
    PG8_STAGE_B(PG8_SB(0, 0), cB); PG8_STAGE_A(PG8_SA(0, 0), cO0, 0u); PG8_STAGE_B(PG8_SB(0, 1), cB + hstep); PG8_STAGE_A(PG8_SA(0, 1), cO1, 0u);
    if (wr == 1) PG8_BAR;
    PG8_WAIT_V(4); PG8_BAR;
    PG8_STAGE_B(PG8_SB(1, 0), cB + kstep); PG8_STAGE_A(PG8_SA(1, 0), cO0, kstep); PG8_STAGE_B(PG8_SB(1, 1), cB + hstep + kstep);
    PG8_WAIT_V(6); PG8_BAR;
    for (;;) {
        const bool has_next = prob.next(ui + 1, nxt);
        const char* nB = cB;
#pragma unroll
        for (int i = 0; i < 2; ++i) { nO0[i] = cO0[i]; nO1[i] = cO1[i]; }
        if (has_next) {
            nB = prob.b_tile(nxt);
#pragma unroll
            for (int i = 0; i < 2; ++i) { nO0[i] = prob.a_row(nxt, RA[i]) + CA2[i]; nO1[i] = prob.a_row(nxt, HALF + RA[i]) + CA2[i]; }
        }
        for (int t = 0; t < nt; t += 2) {
            const bool last = (t == nt - 2);
            const unsigned k1 = (unsigned)(t + 1) * kstep;
            const unsigned k2 = last ? 0u : (unsigned)(t + 2) * kstep, k3 = k2 + kstep;
            unsigned o20[2], o21[2];
#pragma unroll
            for (int i = 0; i < 2; ++i) { o20[i] = last ? nO0[i] : cO0[i]; o21[i] = last ? nO1[i] : cO1[i]; }
            const char* b2 = last ? nB : cB + (size_t)(t + 2) * kstep; const char* b3 = b2 + kstep;
            PG8_LDB(B0, 0, 0); PG8_SCHED; PG8_LDA(At, 0, 0); PG8_STAGE_A(PG8_SA(1, 1), cO1, k1);
            PG8_WAIT_L(8); PG8_BAR; PG8_WAIT_L(0); PG8_MMA(0, 0, At, B0); PG8_BAR; PG8_SCHED;
            PG8_LDB(B1, 0, 1); PG8_STAGE_B(PG8_SB(0, 0), b2);
            PG8_BAR; PG8_WAIT_L(0); PG8_MMA(0, 1, At, B1); PG8_BAR;
            PG8_LDA(At, 0, 1); PG8_STAGE_A(PG8_SA(0, 0), o20, k2);
            PG8_BAR; PG8_WAIT_L(0); PG8_MMA(1, 0, At, B0); PG8_BAR; PG8_SCHED;
            PG8_STAGE_B(PG8_SB(0, 1), b2 + hstep);
            PG8_WAIT_V(6); PG8_BAR; PG8_MMA(1, 1, At, B1); PG8_BAR;
            PG8_LDB(B0, 1, 0); PG8_SCHED; PG8_LDA(At, 1, 0); PG8_STAGE_A(PG8_SA(0, 1), o21, k2);
            PG8_WAIT_L(8); PG8_BAR; PG8_WAIT_L(0); PG8_MMA(0, 0, At, B0); PG8_BAR; PG8_SCHED;
            PG8_LDB(B1, 1, 1); PG8_STAGE_B(PG8_SB(1, 0), b3);
            PG8_BAR; PG8_WAIT_L(0); PG8_MMA(0, 1, At, B1); PG8_BAR;
            PG8_LDA(At, 1, 1); PG8_STAGE_A(PG8_SA(1, 0), o20, k3);
            PG8_BAR; PG8_WAIT_L(0); PG8_MMA(1, 0, At, B0); PG8_BAR; PG8_SCHED;
            PG8_STAGE_B(PG8_SB(1, 1), b3 + hstep);
            PG8_WAIT_V(6); PG8_BAR; PG8_MMA(1, 1, At, B1); PG8_BAR;
        }
        prob.epi(acc, cur, wr, wc, fr, fq);
        if (!has_next) break;
#pragma unroll
        for (int a = 0; a < 2; ++a)
#pragma unroll
            for (int b = 0; b < 2; ++b)
#pragma unroll
                for (int m = 0; m < 4; ++m)
#pragma unroll
                    for (int n = 0; n < 2; ++n) acc[a][b][m][n] = (f32x4){0.f, 0.f, 0.f, 0.f};
        cur = nxt; cB = nB; ++ui;
#pragma unroll
        for (int i = 0; i < 2; ++i) { cO0[i] = nO0[i]; cO1[i] = nO1[i]; }
    }
    PG8_WAIT_V(0);
    if (wr == 0) PG8_BAR;
    PG8_BAR;
#undef PG8_SA
#undef PG8_SB
#undef PG8_STAGE_A
#undef PG8_STAGE_B
#undef PG8_LDA
#undef PG8_LDB
#undef PG8_MMA
#undef PG8_WAIT_V
#undef PG8_WAIT_L
#undef PG8_BAR
#undef PG8_SCHED
}

template <class P>
__device__ __forceinline__ void gemm_phase_f8(LAS unsigned char* lds, const P& prob) {
    const int tid = threadIdx.x, wid = __builtin_amdgcn_readfirstlane(tid >> 6), lane = tid & 63, wr = wid >> 2, wc = wid & 3, fr = lane & 15, fq = lane >> 4;
    const int K = prob.K, nt = K / BK;
    int RA[2]; unsigned CA2[2], voffB[2];
#pragma unroll
    for (int i = 0; i < 2; ++i) { int R, C; stage_rc(tid * 16 + i * 8192, R, C); const int Rb = P::PERM ? ((R & ~31) + perm32(R & 31)) : R;
        RA[i] = R; CA2[i] = (unsigned)C * 2u; voffB[i] = (unsigned)(Rb * K + C) * 2u; }
    const unsigned kstep = (unsigned)(BK * 2);
    const size_t hstep = (size_t)HALF * K * 2;
    const unsigned ldsw = (unsigned)wid * 1024u;
    const int aoff = lds_byte(wr * 64 + fr, fq * 8), boff = lds_byte(wc * 32 + fr, fq * 8);
#define PG8_SA(b, h) (((b) * 2 + (h)) * HTB)
#define PG8_SB(b, h) ((4 + (b) * 2 + (h)) * HTB)
#define PG8_STAGE_B(bufoff, gbase) do { _Pragma("unroll") for (int _i = 0; _i < 2; ++_i) \
        __builtin_amdgcn_global_load_lds((const unsigned*)((const char*)(gbase) + voffB[_i]), (LAS unsigned*)(lds + (bufoff) + ldsw + _i * 8192), 16, 0, 0); } while (0)
#define PG8_STAGE_A(bufoff, offh, kb) do { _Pragma("unroll") for (int _i = 0; _i < 2; ++_i) \
        __builtin_amdgcn_global_load_lds((const unsigned*)(Ab + (size_t)((offh)[_i] + (kb))), (LAS unsigned*)(lds + (bufoff) + ldsw + _i * 8192), 16, 0, 0); } while (0)
#define PG8_LD8(base) __builtin_shufflevector(*(const LAS v4i_t*)(base), *(const LAS v4i_t*)((base) + 1024), 0, 1, 2, 3, 4, 5, 6, 7)
#define PG8_LDA(dst, b, h) do { _Pragma("unroll") for (int m = 0; m < 4; ++m) dst[m] = PG8_LD8(lds + PG8_SA(b, h) + aoff + m * 2048); } while (0)
#define PG8_LDB(dst, b, h) do { _Pragma("unroll") for (int n = 0; n < 2; ++n) dst[n] = PG8_LD8(lds + PG8_SB(b, h) + boff + n * 2048); } while (0)
#define PG8_MMA(ai, bj, At, Bt) do { __builtin_amdgcn_s_setprio(1); _Pragma("unroll") for (int m = 0; m < 4; ++m) _Pragma("unroll") for (int n = 0; n < 2; ++n) \
        asm volatile("v_mfma_scale_f32_16x16x128_f8f6f4 %0, %1, %2, %0, %3, %4 op_sel_hi:[0,0,0]" : "+v"(acc[ai][bj][m][n]) : "v"(Bt[n]), "v"(At[m]), "v"(wsc), "v"(asc)); \
        __builtin_amdgcn_s_setprio(0); } while (0)
#define PG8_WAIT_V(n) asm volatile("s_waitcnt vmcnt(" #n ")" ::: "memory")
#define PG8_WAIT_L(n) asm volatile("s_waitcnt lgkmcnt(" #n ")" ::: "memory")
#define PG8_BAR __builtin_amdgcn_s_barrier()
#define PG8_SCHED __builtin_amdgcn_sched_barrier(0)
    Unit cur, nxt; int ui = 0; const int wsc = 0x7B7B7B7B, asc = P::ASC;
    if (!prob.next(0, cur)) return;
    f32x4 acc[2][2][4][2];
#pragma unroll
    for (int a = 0; a < 2; ++a)
#pragma unroll
        for (int b = 0; b < 2; ++b)
#pragma unroll
            for (int m = 0; m < 4; ++m)
#pragma unroll
                for (int n = 0; n < 2; ++n) acc[a][b][m][n] = (f32x4){0.f, 0.f, 0.f, 0.f};
    v8i_t At[4], B0[2], B1[2];
    const char* Ab = prob.a_base();
    unsigned cO0[2], cO1[2], nO0[2], nO1[2];
#pragma unroll
    for (int i = 0; i < 2; ++i) { cO0[i] = prob.a_row(cur, RA[i]) + CA2[i]; cO1[i] = prob.a_row(cur, HALF + RA[i]) + CA2[i]; }
    const char* cB = prob.b_tile(cur);
    PG8_STAGE_B(PG8_SB(0, 0), cB); PG8_STAGE_A(PG8_SA(0, 0), cO0, 0u); PG8_STAGE_B(PG8_SB(0, 1), cB + hstep); PG8_STAGE_A(PG8_SA(0, 1), cO1, 0u);
    if (wr == 1) PG8_BAR;
    PG8_WAIT_V(4); PG8_BAR;
    PG8_STAGE_B(PG8_SB(1, 0), cB + kstep); PG8_STAGE_A(PG8_SA(1, 0), cO0, kstep); PG8_STAGE_B(PG8_SB(1, 1), cB + hstep + kstep);
    PG8_WAIT_V(6); PG8_BAR;
    for (;;) {
        const bool has_next = prob.next(ui + 1, nxt);
        const char* nB = cB;
#pragma unroll
        for (int i = 0; i < 2; ++i) { nO0[i] = cO0[i]; nO1[i] = cO1[i]; }
        if (has_next) {
            nB = prob.b_tile(nxt);
#pragma unroll
            for (int i = 0; i < 2; ++i) { nO0[i] = prob.a_row(nxt, RA[i]) + CA2[i]; nO1[i] = prob.a_row(nxt, HALF + RA[i]) + CA2[i]; }
        }
        for (int t = 0; t < nt; t += 2) {
            const bool last = (t == nt - 2);
            const unsigned k1 = (unsigned)(t + 1) * kstep;
            const unsigned k2 = last ? 0u : (unsigned)(t + 2) * kstep, k3 = k2 + kstep;
            unsigned o20[2], o21[2];
#pragma unroll
            for (int i = 0; i < 2; ++i) { o20[i] = last ? nO0[i] : cO0[i]; o21[i] = last ? nO1[i] : cO1[i]; }
            const char* b2 = last ? nB : cB + (size_t)(t + 2) * kstep; const char* b3 = b2 + kstep;
            PG8_LDB(B0, 0, 0); PG8_SCHED; PG8_LDA(At, 0, 0); PG8_STAGE_A(PG8_SA(1, 1), cO1, k1);
            PG8_WAIT_L(8); PG8_BAR; PG8_WAIT_L(0); PG8_MMA(0, 0, At, B0); PG8_BAR; PG8_SCHED;
            PG8_LDB(B1, 0, 1); PG8_STAGE_B(PG8_SB(0, 0), b2);
            PG8_BAR; PG8_WAIT_L(0); PG8_MMA(0, 1, At, B1); PG8_BAR;
            PG8_LDA(At, 0, 1); PG8_STAGE_A(PG8_SA(0, 0), o20, k2);
            PG8_BAR; PG8_WAIT_L(0); PG8_MMA(1, 0, At, B0); PG8_BAR; PG8_SCHED;
            PG8_STAGE_B(PG8_SB(0, 1), b2 + hstep);
            PG8_WAIT_V(6); PG8_BAR; PG8_MMA(1, 1, At, B1); PG8_BAR;
            PG8_LDB(B0, 1, 0); PG8_SCHED; PG8_LDA(At, 1, 0); PG8_STAGE_A(PG8_SA(0, 1), o21, k2);
            PG8_WAIT_L(8); PG8_BAR; PG8_WAIT_L(0); PG8_MMA(0, 0, At, B0); PG8_BAR; PG8_SCHED;
            PG8_LDB(B1, 1, 1); PG8_STAGE_B(PG8_SB(1, 0), b3);
            PG8_BAR; PG8_WAIT_L(0); PG8_MMA(0, 1, At, B1); PG8_BAR;
            PG8_LDA(At, 1, 1); PG8_STAGE_A(PG8_SA(1, 0), o20, k3);
            PG8_BAR; PG8_WAIT_L(0); PG8_MMA(1, 0, At, B0); PG8_BAR; PG8_SCHED;
            PG8_STAGE_B(PG8_SB(1, 1), b3 + hstep);
            PG8_WAIT_V(6); PG8_BAR; PG8_MMA(1, 1, At, B1); PG8_BAR;
        }
        asm volatile("s_nop 7\n\ts_nop 7" ::: "memory");
        prob.epi(acc, cur, wr, wc, fr, fq);
        if (!has_next) break;
#pragma unroll
        for (int a = 0; a < 2; ++a)
#pragma unroll
            for (int b = 0; b < 2; ++b)
#pragma unroll
                for (int m = 0; m < 4; ++m)
#pragma unroll
                    for (int n = 0; n < 2; ++n) acc[a][b][m][n] = (f32x4){0.f, 0.f, 0.f, 0.f};
        cur = nxt; cB = nB; ++ui;
#pragma unroll
        for (int i = 0; i < 2; ++i) { cO0[i] = nO0[i]; cO1[i] = nO1[i]; }
    }
    PG8_WAIT_V(0);
    if (wr == 0) PG8_BAR;
    PG8_BAR;
#undef PG8_SA
#undef PG8_SB
#undef PG8_STAGE_A
#undef PG8_STAGE_B
#undef PG8_LDA
#undef PG8_LDB
#undef PG8_MMA
#undef PG8_LD8
#undef PG8_WAIT_V
#undef PG8_WAIT_L
#undef PG8_BAR
#undef PG8_SCHED
}


struct StaticOrder {
    int nM, nN, nwg, G, c;
    __device__ void init(int M, int N, int G_, int c_) { nM = M / BM; nN = N / BM; nwg = nM * nN; G = G_; c = c_; }
    __device__ bool next(int i, Unit& u) const {
        const long L = (long)i * G + c; if (L >= nwg) return false;
        int wgid = (int)L; { const int q = nwg / 8, r = nwg % 8, xcd = wgid % 8, off = wgid / 8; wgid = (xcd < r ? xcd * (q + 1) : r * (q + 1) + (xcd - r) * q) + off; }
        const int nig = 8 * nN, gid = wgid / nig, fm = gid * 8, gsz = (nM - fm) < 8 ? (nM - fm) : 8;
        u.pm = fm + ((wgid % nig) % gsz); u.pn = (wgid % nig) / gsz; u.e = 0; u.cnt = 256; return true;
    }
};
}
using pg8::Unit;
typedef f32x4 AccT[2][2][4][2];

struct ProbInProj {
    static constexpr bool PERM = true;
    int K; pg8::StaticOrder S; const char* A; const char* Bt; const int* pos; bf16_t *Qp, *Kp, *Vp, *Gp, *Bp, *Up;
    __device__ __forceinline__ bool next(int i, Unit& u) const { return S.next(i, u); }
    __device__ __forceinline__ const char* a_base() const { return A; }
    __device__ __forceinline__ unsigned a_row(const Unit& u, int r) const { return (unsigned)(u.pm * 256 + r) * (unsigned)(DM * 2); }
    __device__ __forceinline__ const char* b_tile(const Unit& u) const { return Bt + (size_t)u.pn * 256 * DM * 2; }
    __device__ __forceinline__ void epi(const AccT& acc, const Unit& u, int wr, int wc, int fr, int fq) const {
        const int row0 = u.pm * 256 + wr * 64 + fr, pn = u.pn;
        if (pn < 4) {
            bf16_t* dst = Qp + (size_t)(pn >> 1) * ((size_t)NTOK * 512); const float sc = pn >= 2 ? 0.125f : 1.0f; const int head = 4 * (pn & 1) + wc;
            float invf[8];
#pragma unroll
            for (int q = 0; q < 8; ++q) invf[q] = __builtin_amdgcn_exp2f(-(float)(8 * fq + q) * (13.287712379549449f / 32.f)) * 0.15915494309189535f;
#pragma unroll
            for (int ai = 0; ai < 2; ++ai)
#pragma unroll
                for (int m = 0; m < 4; ++m) {
                    const int tok = row0 + ai * 128 + m * 16; const float p = (float)pos[tok];
                    float o1[8], o2[8];
#pragma unroll
                    for (int n = 0; n < 2; ++n)
#pragma unroll
                        for (int j = 0; j < 4; ++j) {
                            float rev = p * invf[4 * n + j]; rev = rev - __builtin_floorf(rev);
                            const float sn = __builtin_amdgcn_sinf(rev), cs = __builtin_amdgcn_cosf(rev);
                            const float t1 = acc[ai][0][m][n][j], t2 = acc[ai][1][m][n][j];
                            o1[4 * n + j] = (t1 * cs - t2 * sn) * sc; o2[4 * n + j] = (t2 * cs + t1 * sn) * sc;
                        }
                    bf16_t* rp = dst + (size_t)tok * 512 + head * 64 + 8 * fq;
                    u32x4 w1, w2;
                    w1.x = cvt_pk_bf16(o1[0], o1[1]); w1.y = cvt_pk_bf16(o1[2], o1[3]); w1.z = cvt_pk_bf16(o1[4], o1[5]); w1.w = cvt_pk_bf16(o1[6], o1[7]);
                    w2.x = cvt_pk_bf16(o2[0], o2[1]); w2.y = cvt_pk_bf16(o2[2], o2[3]); w2.z = cvt_pk_bf16(o2[4], o2[5]); w2.w = cvt_pk_bf16(o2[6], o2[7]);
                    *(u32x4*)rp = w1; *(u32x4*)(rp + 32) = w2;
                }
        } else if (pn < 10) {
            const int grp = (pn - 4) >> 1; bf16_t* dst = Vp + (size_t)grp * ((size_t)NTOK * 512); const bool act = grp == 1;
            const int col0 = (pn & 1) * 256 + wc * 32 + 8 * fq;
#pragma unroll
            for (int ai = 0; ai < 2; ++ai)
#pragma unroll
                for (int m = 0; m < 4; ++m) {
                    bf16_t* rp = dst + (size_t)(row0 + ai * 128 + m * 16) * 512 + col0;
#pragma unroll
                    for (int bj = 0; bj < 2; ++bj) {
                        f32x4 v0 = acc[ai][bj][m][0], v1 = acc[ai][bj][m][1];
                        if (act) {
#pragma unroll
                            for (int j = 0; j < 4; ++j) { v0[j] = fast_silu(v0[j]); v1[j] = fast_silu(v1[j]); }
                        }
                        u32x4 w; w.x = cvt_pk_bf16(v0[0], v0[1]); w.y = cvt_pk_bf16(v0[2], v0[3]); w.z = cvt_pk_bf16(v1[0], v1[1]); w.w = cvt_pk_bf16(v1[2], v1[3]);
                        *(u32x4*)(rp + bj * 128) = w;
                    }
                }
        } else {
            const int ch0 = 128 * (pn - 10) + wc * 32 + 8 * fq;
#pragma unroll
            for (int ai = 0; ai < 2; ++ai)
#pragma unroll
                for (int m = 0; m < 4; ++m) {
                    const f32x4 v0 = acc[ai][0][m][0] * acc[ai][1][m][0], v1 = acc[ai][0][m][1] * acc[ai][1][m][1];
                    u32x4 w; w.x = cvt_pk_bf16(v0[0], v0[1]); w.y = cvt_pk_bf16(v0[2], v0[3]); w.z = cvt_pk_bf16(v1[0], v1[1]); w.w = cvt_pk_bf16(v1[2], v1[3]);
                    *(u32x4*)(Up + (size_t)(row0 + ai * 128 + m * 16) * 512 + ch0) = w;
                }
        }
    }
};

struct ProbOutProj {
    static constexpr bool PERM = true;
    int K; pg8::StaticOrder S; const char* A; const char* Bt; const float* x; const float* mod; bf16_t* x1;
    __device__ __forceinline__ bool next(int i, Unit& u) const { return S.next(i, u); }
    __device__ __forceinline__ const char* a_base() const { return A; }
    __device__ __forceinline__ unsigned a_row(const Unit& u, int r) const { return (unsigned)(u.pm * 256 + r) * (unsigned)(DM * 2); }
    __device__ __forceinline__ const char* b_tile(const Unit& u) const { return Bt + (size_t)u.pn * 256 * DM * 2; }
    __device__ __forceinline__ void epi(const AccT& acc, const Unit& u, int wr, int wc, int fr, int fq) const {
        const int row0 = u.pm * 256 + wr * 64 + fr, col0 = u.pn * 256 + wc * 32 + 8 * fq;
        const float* gate = mod + (size_t)(u.pm >> 3) * MODW + 2 * DM;
        f32x4 gv[2][2];
#pragma unroll
        for (int bj = 0; bj < 2; ++bj)
#pragma unroll
            for (int n = 0; n < 2; ++n) gv[bj][n] = *(const f32x4*)(gate + col0 + bj * 128 + n * 4);
#pragma unroll
        for (int ai = 0; ai < 2; ++ai)
#pragma unroll
            for (int m = 0; m < 4; ++m) {
                const size_t off = (size_t)(row0 + ai * 128 + m * 16) * DM + col0;
#pragma unroll
                for (int bj = 0; bj < 2; ++bj) {
                    const f32x4 x0 = *(const f32x4*)(x + off + bj * 128), x1v = *(const f32x4*)(x + off + bj * 128 + 4);
                    const f32x4 v0 = x0 + gv[bj][0] * acc[ai][bj][m][0], v1 = x1v + gv[bj][1] * acc[ai][bj][m][1];
                    u32x4 w; w.x = cvt_pk_bf16(v0[0], v0[1]); w.y = cvt_pk_bf16(v0[2], v0[3]); w.z = cvt_pk_bf16(v1[0], v1[1]); w.w = cvt_pk_bf16(v1[2], v1[3]);
                    *(u32x4*)(x1 + off + bj * 128) = w;
                }
            }
    }
};

struct MoeOrder {
    const LAS int* pre;
    const LAS int* cnts;
    int G, c, NT;
    __device__ __forceinline__ bool next(int i, Unit& u) const {
        int L = i * G + c;
        const int total = __builtin_amdgcn_readfirstlane(pre[32]);
        if (L >= total) return false;
        { const int q = total >> 3, r = total & 7, xcd = L & 7, off = L >> 3; L = (xcd < r ? xcd * (q + 1) : r * (q + 1) + (xcd - r) * q) + off; }
        int e = 0;
        for (int j = 1; j < 32; ++j) e += (__builtin_amdgcn_readfirstlane(pre[j]) <= L) ? 1 : 0;
        const int cnt = __builtin_amdgcn_readfirstlane(cnts[e]), tiles = (cnt + 255) >> 8, local = L - __builtin_amdgcn_readfirstlane(pre[e]);
        u.e = e; u.cnt = cnt; u.pn = local / tiles; u.pm = local - u.pn * tiles; return true;
    }
};
struct ProbMoe1 {
    static constexpr bool PERM = true; static constexpr int ASC = 0x7F7F7F7F;
    int K; MoeOrder S; const char* A; const char* Bt; const int* lists; const float* pw; bf16_t* hid;
    __device__ __forceinline__ bool next(int i, Unit& u) const { return S.next(i, u); }
    __device__ __forceinline__ const char* a_base() const { return A; }
    __device__ __forceinline__ unsigned a_row(const Unit& u, int r) const { int s = u.pm * 256 + r; s = s < u.cnt ? s : u.cnt - 1; const int p = lists[u.e * LCAP + s]; return (unsigned)(p >> 1) * (unsigned)DM; }
    __device__ __forceinline__ const char* b_tile(const Unit& u) const { return Bt + ((size_t)u.e * 4 + u.pn) * 256 * DM; }
    __device__ __forceinline__ void epi(const AccT& acc, const Unit& u, int wr, int wc, int fr, int fq) const {
        const int col0 = u.pn * 128 + wc * 32 + 8 * fq;
#pragma unroll
        for (int ai = 0; ai < 2; ++ai)
#pragma unroll
            for (int m = 0; m < 4; ++m) {
                const int s = u.pm * 256 + ai * 128 + wr * 64 + m * 16 + fr;
                if (s < u.cnt) {
                    const int p = lists[u.e * LCAP + s]; const float w = pw[p];
                    const f32x4 a0 = acc[ai][0][m][0], a1 = acc[ai][0][m][1], u0 = acc[ai][1][m][0], u1 = acc[ai][1][m][1];
                    float o[8];
#pragma unroll
                    for (int j = 0; j < 4; ++j) { o[j] = fast_silu(a0[j]) * u0[j] * w; o[4 + j] = fast_silu(a1[j]) * u1[j] * w; }
                    int q0 = __builtin_amdgcn_cvt_pk_fp8_f32(o[0] * 8.f, o[1] * 8.f, 0, false); q0 = __builtin_amdgcn_cvt_pk_fp8_f32(o[2] * 8.f, o[3] * 8.f, q0, true);
                    int q1 = __builtin_amdgcn_cvt_pk_fp8_f32(o[4] * 8.f, o[5] * 8.f, 0, false); q1 = __builtin_amdgcn_cvt_pk_fp8_f32(o[6] * 8.f, o[7] * 8.f, q1, true);
                    u32x2 wv; wv.x = (unsigned)q0; wv.y = (unsigned)q1;
                    *(u32x2*)((unsigned char*)hid + (size_t)p * DE + col0) = wv;
                }
            }
    }
};
struct ProbMoe2 {
    static constexpr bool PERM = true; static constexpr int ASC = 0x7C7C7C7C;
    int K; MoeOrder S; const char* A; const char* Bt; const int* lists; bf16_t* opair;
    __device__ __forceinline__ bool next(int i, Unit& u) const { return S.next(i, u); }
    __device__ __forceinline__ const char* a_base() const { return A; }
    __device__ __forceinline__ unsigned a_row(const Unit& u, int r) const { int s = u.pm * 256 + r; s = s < u.cnt ? s : u.cnt - 1; const int p = lists[u.e * LCAP + s]; return (unsigned)p * (unsigned)DE; }
    __device__ __forceinline__ const char* b_tile(const Unit& u) const { return Bt + ((size_t)u.e * 4 + u.pn) * 256 * DE; }
    __device__ __forceinline__ void epi(const AccT& acc, const Unit& u, int wr, int wc, int fr, int fq) const {
        const int col0 = u.pn * 256 + wc * 32 + 8 * fq;
#pragma unroll
        for (int ai = 0; ai < 2; ++ai)
#pragma unroll
            for (int m = 0; m < 4; ++m) {
                const int s = u.pm * 256 + ai * 128 + wr * 64 + m * 16 + fr;
                if (s < u.cnt) {
                    const int p = lists[u.e * LCAP + s];
                    unsigned char* rp = (unsigned char*)opair + (size_t)p * DM + col0;
#pragma unroll
                    for (int bj = 0; bj < 2; ++bj) {
                        const f32x4 v0 = acc[ai][bj][m][0] * 16.f, v1 = acc[ai][bj][m][1] * 16.f;
                        int q0 = __builtin_amdgcn_cvt_pk_fp8_f32(v0[0], v0[1], 0, false); q0 = __builtin_amdgcn_cvt_pk_fp8_f32(v0[2], v0[3], q0, true);
                        int q1 = __builtin_amdgcn_cvt_pk_fp8_f32(v1[0], v1[1], 0, false); q1 = __builtin_amdgcn_cvt_pk_fp8_f32(v1[2], v1[3], q1, true);
                        u32x2 w; w.x = (unsigned)q0; w.y = (unsigned)q1;
                        *(u32x2*)(rp + bj * 128) = w;
                    }
                }
            }
    }
};
__device__ __forceinline__ void moe_tables(const int* counts, LAS int* pre, LAS int* cnts) {
    if (threadIdx.x < 64) {
        const int l = threadIdx.x; const int cnt = l < 32 ? counts[l] : 0; const int un = ((cnt + 255) >> 8) * 4;
        int incl = un;
#pragma unroll
        for (int o = 1; o < 32; o <<= 1) { const int t = __shfl_up(incl, o); if ((l & 31) >= o) incl += t; }
        if (l < 32) { cnts[l] = cnt; pre[l + 1] = incl; }
        if (l == 0) pre[0] = 0;
    }
    __syncthreads();
}

__device__ __forceinline__ int win_srccol(int nb) {
    const int pn = nb >> 3, q = nb & 7;
    if (pn < 4) return (pn >= 2 ? 512 : 0) + (4 * (pn & 1) + (q & 3)) * 64 + (q >> 2) * 32;
    if (pn < 10) return 1024 + (pn - 4) * 256 + 32 * q;
    const int j = pn - 10; return q < 4 ? 2560 + 128 * j + 32 * q : 3072 + 128 * j + 32 * (q - 4);
}
struct TileDesc { __amdgpu_buffer_rsrc_t rs, rd; unsigned rstep, dstep; };
template <int KIND> __device__ __forceinline__ TileDesc tile_desc(const Args& a, int tt) {
    const int t = __builtin_amdgcn_readfirstlane(tt);
    const float* src; int ldn, col0, k0; bf16_t* dst; int ldk;
    if (KIND == 0) {
        const int isout = t >= 896 ? 1 : 0, u = t - 896 * isout, nb = u >> 3, kb = u & 7;
        src = (const float*)((const char*)a.w_in + ((const char*)a.w_out - (const char*)a.w_in) * (ptrdiff_t)isout); ldn = isout ? DM : INC; col0 = isout ? nb * 32 : win_srccol(nb); k0 = kb * 128;
        dst = (bf16_t*)((char*)a.WinT + ((char*)a.WoutT - (char*)a.WinT) * (ptrdiff_t)isout) + (size_t)nb * 32 * DM; ldk = DM;
    } else if (KIND == 1) {
        const int e = t >> 8, v = t & 255, nb = v >> 3, kb = v & 7, pn = nb >> 3, q = nb & 7;
        src = (const float*)((const char*)a.ewg + ((const char*)a.ewu - (const char*)a.ewg) * (ptrdiff_t)(q >> 2)) + (size_t)e * DM * DE; ldn = DE; col0 = 128 * pn + 32 * (q & 3); k0 = kb * 128;
        dst = (bf16_t*)(a.W1Q + ((size_t)e * 1024 + nb * 32) * DM) ; ldk = DM / 2;
    } else {
        const int e = t >> 7, v = t & 127, nb = v >> 2, kb = v & 3;
        src = a.ewd + (size_t)e * DE * DM; ldn = DM; col0 = nb * 32; k0 = kb * 128;
        dst = (bf16_t*)(a.W2Q + ((size_t)e * 1024 + nb * 32) * DE); ldk = DE / 2;
    }
    TileDesc d;
    d.rs = __builtin_amdgcn_make_buffer_rsrc((void*)(src + (size_t)k0 * ldn + col0), 0, 128 * ldn * 4, 0x00020000);
    d.rd = __builtin_amdgcn_make_buffer_rsrc(KIND == 0 ? (void*)(dst + k0) : (void*)((unsigned char*)dst + k0), 0, 32 * ldk * 2, 0x00020000);
    d.rstep = (unsigned)(8 * ldn * 4); d.dstep = (unsigned)(ldk * 2);
    return d;
}
#define CT_LOAD(V, D) do { const unsigned vo_ = ((unsigned)(lane >> 3) * ((D).rstep >> 3)) + 16u * (unsigned)(lane & 7); \
        _Pragma("unroll") for (int i_ = 0; i_ < 16; ++i_) V[i_] = __builtin_bit_cast(f32x4, __builtin_amdgcn_raw_buffer_load_b128((D).rs, (int)vo_, (int)(i_ * (D).rstep), 0)); } while (0)
#define CT_EMIT(V, D) do { \
        _Pragma("unroll") for (int i_ = 0; i_ < 16; ++i_) _Pragma("unroll") for (int j_ = 0; j_ < 4; ++j_) T[(4 * (lane & 7) + j_) * 130 + 8 * i_ + (lane >> 3)] = V[i_][j_]; \
        __builtin_amdgcn_wave_barrier(); \
        _Pragma("unroll") for (int nn_ = 0; nn_ < 32; ++nn_) { const float lo_ = T[nn_ * 130 + 2 * lane], hi_ = T[nn_ * 130 + 2 * lane + 1]; \
            __builtin_amdgcn_raw_buffer_store_b32(cvt_pk_bf16(lo_, hi_), (D).rd, 4 * lane, (int)(nn_ * (D).dstep), 0); } \
        __builtin_amdgcn_wave_barrier(); } while (0)
#define CT_EMIT8(V, D) do { \
        _Pragma("unroll") for (int i_ = 0; i_ < 16; ++i_) _Pragma("unroll") for (int j_ = 0; j_ < 4; ++j_) T[(4 * (lane & 7) + j_) * 130 + 8 * i_ + (lane >> 3)] = V[i_][j_]; \
        __builtin_amdgcn_wave_barrier(); \
        _Pragma("unroll") for (int it_ = 0; it_ < 16; ++it_) { const LAS float* tp_ = T + (2 * it_ + (lane >> 5)) * 130 + 4 * (lane & 31); \
            int pk_ = __builtin_amdgcn_cvt_pk_fp8_f32(tp_[0] * 16.f, tp_[1] * 16.f, 0, false); pk_ = __builtin_amdgcn_cvt_pk_fp8_f32(tp_[2] * 16.f, tp_[3] * 16.f, pk_, true); \
            __builtin_amdgcn_raw_buffer_store_b32((unsigned)pk_, (D).rd, (int)((unsigned)(lane >> 5) * (D).dstep + 4u * (unsigned)(lane & 31)), (int)(2 * it_ * (D).dstep), 0); } \
        __builtin_amdgcn_wave_barrier(); } while (0)
#define CT_EMITK(V, D) do { if (KIND == 0) CT_EMIT(V, D); else CT_EMIT8(V, D); } while (0)
template <int KIND> __device__ __forceinline__ void convert_tiles(const Args& a, LAS float* T, int tbeg, int tend, int step, int lane) {
    if (tbeg >= tend) return;
    const int n = (tend - tbeg + step - 1) / step, n3 = (n / 3) * 3;
    int t = tbeg;
    if (n3 > 0) {
        const int tl3 = tbeg + (n3 - 1) * step;
        f32x4 va[16], vb[16], vc[16];
        TileDesc da = tile_desc<KIND>(a, t), db = tile_desc<KIND>(a, t + step), dc;
        CT_LOAD(va, da); CT_LOAD(vb, db);
        for (; t <= tl3; t += 3 * step) {
            const int t3 = t + 3 * step <= tl3 ? t + 3 * step : tl3, t4 = t + 4 * step <= tl3 ? t + 4 * step : tl3;
            dc = tile_desc<KIND>(a, t + 2 * step); CT_LOAD(vc, dc);
            CT_EMITK(va, da);
            da = tile_desc<KIND>(a, t3); CT_LOAD(va, da);
            CT_EMITK(vb, db);
            db = tile_desc<KIND>(a, t4); CT_LOAD(vb, db);
            CT_EMITK(vc, dc);
        }
    }
    for (; t < tend; t += step) { f32x4 v[16]; const TileDesc d = tile_desc<KIND>(a, t); CT_LOAD(v, d); CT_EMITK(v, d); }
}
__device__ __forceinline__ void phase_prep(const Args& a, LAS unsigned char* lds) {
    const int tid = threadIdx.x, lane = tid & 63, wid = tid >> 6;
    {
        LAS float* sc = (LAS float*)lds; LAS float* red = (LAS float*)(lds + 32768);
        for (int i = tid; i < NB * DM; i += NTHR) { const float v = a.c[i]; sc[i] = v / (1.f + __expf(-v)); }
        __syncthreads();
        for (int cg = blockIdx.x; cg < 256; cg += gridDim.x) {
            const int ks = tid / 6, c4 = tid % 6;
            if (tid < 510) {
                f32x4 ac[NB];
#pragma unroll
                for (int b = 0; b < NB; ++b) ac[b] = (f32x4){0.f, 0.f, 0.f, 0.f};
                for (int k = ks; k < DM; k += 85) {
                    const f32x4 w = *(const f32x4*)(a.ada_w + (size_t)k * MODW + cg * 24 + c4 * 4);
#pragma unroll
                    for (int b = 0; b < NB; ++b) ac[b] += w * sc[b * DM + k];
                }
#pragma unroll
                for (int b = 0; b < NB; ++b) *(LAS f32x4*)(red + (ks * 6 + c4) * 32 + b * 4) = ac[b];
            }
            __syncthreads();
            if (tid < 192) {
                const int b = tid / 24, col = tid % 24, cc = col >> 2, j = col & 3; float s = 0.f;
                for (int q = 0; q < 85; ++q) s += red[(q * 6 + cc) * 32 + b * 4 + j];
                a.mod[b * MODW + cg * 24 + col] = s + a.ada_b[cg * 24 + col];
            }
            __syncthreads();
        }
    }
    {
        for (int i = blockIdx.x * NTHR + tid; i < 48 * DM; i += gridDim.x * NTHR) {
            const int j = i >> 10, k = i & 1023; float v = 0.f;
            if (j < 4) v = a.rgw[k * 4 + j]; else if (j < 36) v = a.rew[k * 32 + (j - 4)];
            a.WrT[i] = (bf16_t)(cvt_pk_bf16(v, 0.f) & 0xffffu);
        }
    }
    {
        convert_tiles<0>(a, (LAS float*)(lds + wid * 16640), blockIdx.x * 8 + wid, 1152, gridDim.x * 8, lane);
        if (W1_PRE > 0) convert_tiles<1>(a, (LAS float*)(lds + wid * 16640), blockIdx.x * 8 + wid, W1_PRE, gridDim.x * 8, lane);
        if (W2_PRE > 0) convert_tiles<2>(a, (LAS float*)(lds + wid * 16640), blockIdx.x * 8 + wid, W2_PRE, gridDim.x * 8, lane);
    }
}

__device__ __forceinline__ void load_mod_consts(const float* g, const float* mod_b, int shift_off, int scale_off, int lane, float (&Am)[16], float (&Bm)[16]) {
#pragma unroll
    for (int i = 0; i < 4; ++i) {
        const int k = 256 * i + 4 * lane;
        const f32x4 gv = *(const f32x4*)(g + k), sc = *(const f32x4*)(mod_b + scale_off + k), sh = *(const f32x4*)(mod_b + shift_off + k);
#pragma unroll
        for (int j = 0; j < 4; ++j) { Am[4 * i + j] = gv[j] * (1.f + sc[j]); Bm[4 * i + j] = sh[j]; }
    }
}
__device__ __forceinline__ void phase_norm1(const Args& a) {
    const int tid = threadIdx.x, lane = tid & 63, wid = tid >> 6, b = blockIdx.x >> 5;
    float Am[16], Bm[16];
    load_mod_consts(a.g_mix, a.mod + (size_t)b * MODW, 0, DM, lane, Am, Bm);
    for (int q = 0; q < 8; ++q) {
        const int row = blockIdx.x * 64 + wid * 8 + q;
        const float* xr = a.x + (size_t)row * DM + 4 * lane;
        f32x4 v[4]; float ss = 0.f;
#pragma unroll
        for (int i = 0; i < 4; ++i) { v[i] = *(const f32x4*)(xr + 256 * i); ss += v[i][0] * v[i][0] + v[i][1] * v[i][1] + v[i][2] * v[i][2] + v[i][3] * v[i][3]; }
        ss = wave_sum(ss);
        const float rs = __builtin_amdgcn_rsqf(ss * (1.f / DM) + 1e-6f);
        bf16_t* hr = a.h + (size_t)row * DM + 4 * lane;
#pragma unroll
        for (int i = 0; i < 4; ++i) {
            u32x2 w; w.x = cvt_pk_bf16(v[i][0] * rs * Am[4 * i] + Bm[4 * i], v[i][1] * rs * Am[4 * i + 1] + Bm[4 * i + 1]);
            w.y = cvt_pk_bf16(v[i][2] * rs * Am[4 * i + 2] + Bm[4 * i + 2], v[i][3] * rs * Am[4 * i + 3] + Bm[4 * i + 3]);
            *(u32x2*)(hr + 256 * i) = w;
        }
    }
}

constexpr int RLD = 72;
constexpr int RT = 64 * RLD * 2;
__device__ __forceinline__ bf16x8 lds_row8(const LAS unsigned char* base, int row, int col) { return *(const LAS bf16x8*)(base + (row * RLD + col) * 2); }
__device__ __forceinline__ bf16x8 lds_tr8(const LAS unsigned char* base, int kbase, int c16, int lane) {
    const int g = lane >> 4, q = (lane & 15) >> 2, p = lane & 3;
    const LAS unsigned char* ad = base + ((kbase + 8 * g + q) * RLD + 16 * c16 + 4 * p) * 2;
    const s16x4 lo = __builtin_amdgcn_ds_read_tr16_b64_v4i16((LAS s16x4*)ad);
    const s16x4 hi = __builtin_amdgcn_ds_read_tr16_b64_v4i16((LAS s16x4*)(ad + 4 * RLD * 2));
    return __builtin_shufflevector(lo, hi, 0, 1, 2, 3, 4, 5, 6, 7);
}
__device__ __forceinline__ u32x4 scale_bf16x8(u32x4 v, float s) {
    u32x4 r;
    r.x = cvt_pk_bf16(bf_lo(v.x) * s, bf_hi(v.x) * s); r.y = cvt_pk_bf16(bf_lo(v.y) * s, bf_hi(v.y) * s);
    r.z = cvt_pk_bf16(bf_lo(v.z) * s, bf_hi(v.z) * s); r.w = cvt_pk_bf16(bf_lo(v.w) * s, bf_hi(v.w) * s);
    return r;
}

__device__ __forceinline__ void phase_conv_seg(const Args& a, LAS unsigned char* lds) {
    const int tid = threadIdx.x, lane = tid & 63, wid = tid >> 6;
    {
        const int t0 = blockIdx.x * 64 + wid * 8, c0 = 8 * lane;
        float w0[8], w1[8], w2[8], cb[8], bt[8];
#pragma unroll
        for (int j = 0; j < 8; ++j) { w0[j] = a.conv_w[c0 + j]; w1[j] = a.conv_w[512 + c0 + j]; w2[j] = a.conv_w[1024 + c0 + j]; cb[j] = a.conv_b[c0 + j]; bt[j] = a.beta_conv[c0 + j]; }
        u32x4 um1 = (u32x4){0u, 0u, 0u, 0u}, um2 = um1;
        if ((t0 & (SEQ - 1)) != 0) { um1 = *(const u32x4*)(a.Up + (size_t)(t0 - 1) * 512 + c0); um2 = *(const u32x4*)(a.Up + (size_t)(t0 - 2) * 512 + c0); }
#pragma unroll 2
        for (int q = 0; q < 8; ++q) {
            const int t = t0 + q;
            const u32x4 uc = *(const u32x4*)(a.Up + (size_t)t * 512 + c0), bg = *(const u32x4*)(a.Bp + (size_t)t * 512 + c0);
            float y[8]; float ss = 0.f;
#pragma unroll
            for (int j2 = 0; j2 < 4; ++j2) {
                const unsigned cw = uc[j2], m1 = um1[j2], m2 = um2[j2], bw = bg[j2];
                const float y0 = bf_lo(bw) * (w0[2 * j2] * bf_lo(m2) + w1[2 * j2] * bf_lo(m1) + w2[2 * j2] * bf_lo(cw) + cb[2 * j2]);
                const float y1 = bf_hi(bw) * (w0[2 * j2 + 1] * bf_hi(m2) + w1[2 * j2 + 1] * bf_hi(m1) + w2[2 * j2 + 1] * bf_hi(cw) + cb[2 * j2 + 1]);
                y[2 * j2] = y0; y[2 * j2 + 1] = y1; ss += y0 * y0 + y1 * y1;
            }
            ss += __shfl_xor(ss, 1); ss += __shfl_xor(ss, 2); ss += __shfl_xor(ss, 4);
            const float rs = __builtin_amdgcn_rsqf(ss * (1.f / 64.f) + 1e-6f);
            u32x4 w; w.x = cvt_pk_bf16(y[0] * rs * bt[0], y[1] * rs * bt[1]); w.y = cvt_pk_bf16(y[2] * rs * bt[2], y[3] * rs * bt[3]);
            w.z = cvt_pk_bf16(y[4] * rs * bt[4], y[5] * rs * bt[5]); w.w = cvt_pk_bf16(y[6] * rs * bt[6], y[7] * rs * bt[7]);
            *(u32x4*)(a.Y + (size_t)t * DM + 512 + c0) = w;
            um2 = um1; um1 = uc;
        }
    }
    {
        const int u = blockIdx.x, b = u >> 5, hh = (u >> 2) & 7, seg = u & 3;
        const float l2g = __builtin_log2f(1.f - __builtin_amdgcn_exp2f(-5.f - (float)hh));
        const float cdec = __builtin_amdgcn_exp2f(l2g * 64.f);
        const int m = tid >> 3, c8 = (tid & 7) * 8;
        const float kdec = __builtin_amdgcn_exp2f(l2g * (float)(63 - m));
        const size_t tok0 = (size_t)b * SEQ + seg * 512;
        const int di = wid >> 1, ei0 = 2 * (wid & 1), g = lane >> 4;
        f32x4 st[2] = {(f32x4){0.f, 0.f, 0.f, 0.f}, (f32x4){0.f, 0.f, 0.f, 0.f}};
        u32x4 kr = *(const u32x4*)(a.Kp + (tok0 + m) * 512 + hh * 64 + c8), vr = *(const u32x4*)(a.Vp + (tok0 + m) * 512 + hh * 64 + c8);
        for (int j = 0; j < 8; ++j) {
            LAS unsigned char* Kd = lds + (j & 1) * 2 * RT; LAS unsigned char* Vs = Kd + RT;
            *(LAS u32x4*)(Kd + (m * RLD + c8) * 2) = scale_bf16x8(kr, kdec);
            *(LAS u32x4*)(Vs + (m * RLD + c8) * 2) = vr;
            __syncthreads();
            if (j + 1 < 8) { kr = *(const u32x4*)(a.Kp + (tok0 + (j + 1) * 64 + m) * 512 + hh * 64 + c8); vr = *(const u32x4*)(a.Vp + (tok0 + (j + 1) * 64 + m) * 512 + hh * 64 + c8); }
            st[0] *= cdec; st[1] *= cdec;
#pragma unroll
            for (int ks = 0; ks < 2; ++ks) {
                const bf16x8 af = lds_tr8(Kd, 32 * ks, di, lane);
#pragma unroll
                for (int e = 0; e < 2; ++e) { const bf16x8 bfv = lds_tr8(Vs, 32 * ks, ei0 + e, lane); st[e] = __builtin_amdgcn_mfma_f32_16x16x32_bf16(af, bfv, st[e], 0, 0, 0); }
            }
        }
        float* so = a.sseg + (size_t)u * 4096;
#pragma unroll
        for (int e = 0; e < 2; ++e)
#pragma unroll
            for (int r = 0; r < 4; ++r) __hip_atomic_store(so + (16 * di + 4 * g + r) * 64 + 16 * (ei0 + e) + (lane & 15), st[e][r], __ATOMIC_RELAXED, __HIP_MEMORY_SCOPE_AGENT);
        asm volatile("s_waitcnt vmcnt(0)" ::: "memory");
        __syncthreads();
        if (tid == 0) __hip_atomic_store(a.segflag + 16 * u, 1u, __ATOMIC_RELAXED, __HIP_MEMORY_SCOPE_AGENT);
    }
}

__device__ __forceinline__ void phase_ret_out(const Args& a, LAS unsigned char* lds) {
    const int tid = threadIdx.x, lane = tid & 63, wid = __builtin_amdgcn_readfirstlane(tid >> 6), g = lane >> 4, l15 = lane & 15;
    const int u = blockIdx.x, b = u >> 5, hh = (u >> 2) & 7, seg = u & 3;
    const float l2g = __builtin_log2f(1.f - __builtin_amdgcn_exp2f(-5.f - (float)hh));
    const float cdec = __builtin_amdgcn_exp2f(l2g * 64.f);
    const int m = tid >> 3, c8 = (tid & 7) * 8;
    const float kdec = __builtin_amdgcn_exp2f(l2g * (float)(63 - m));
    const size_t tok0 = (size_t)b * SEQ + seg * 512;
    LAS unsigned char* Ps = lds + 8 * RT; LAS unsigned char* Stb = lds + 9 * RT;
    f32x4 st[4];
#pragma unroll
    for (int e = 0; e < 4; ++e) st[e] = (f32x4){0.f, 0.f, 0.f, 0.f};
    float bt[16];
#pragma unroll
    for (int e = 0; e < 4; ++e)
#pragma unroll
        for (int r = 0; r < 4; ++r) bt[4 * e + r] = a.beta_ret[hh * 64 + 16 * e + 4 * g + r];
    if (seg > 0) {
        if (wid == 0) {
            unsigned sp = 0;
            for (int s2 = 0; s2 < seg; ++s2) {
                while (__builtin_amdgcn_readfirstlane(__hip_atomic_load(a.segflag + 16 * (u - seg + s2), __ATOMIC_RELAXED, __HIP_MEMORY_SCOPE_AGENT)) == 0u) {
                    __builtin_amdgcn_s_sleep(1);
                    if (++sp > (1u << 20)) { if (lane == 0) atomicAdd(&a.bar[XB_TMO], 1u); break; }
                }
            }
            __builtin_amdgcn_fence(__ATOMIC_ACQUIRE, "agent");
            asm volatile("s_waitcnt vmcnt(0)" ::: "memory");
        }
        __syncthreads();
    }
    if (wid >= 4) {
        const int di = wid - 4;
        for (int s2 = 0; s2 < seg; ++s2) {
            const float wgt = __builtin_amdgcn_exp2f(l2g * 512.f * (float)(seg - 1 - s2));
            const float* sp = a.sseg + (size_t)(u - seg + s2) * 4096;
#pragma unroll
            for (int e = 0; e < 4; ++e)
#pragma unroll
                for (int r = 0; r < 4; ++r) st[e][r] += wgt * sp[(16 * di + 4 * g + r) * 64 + 16 * e + l15];
        }
#pragma unroll
        for (int e = 0; e < 4; ++e) { u32x2 w; w.x = cvt_pk_bf16(st[e][0], st[e][1]); w.y = cvt_pk_bf16(st[e][2], st[e][3]); *(LAS u32x2*)(Stb + ((16 * e + l15) * RLD + 16 * di + 4 * g) * 2) = w; }
    }
    const bf16_t* qp = a.Qp + (tok0 + m) * 512 + hh * 64 + c8; const bf16_t* kp = a.Kp + (tok0 + m) * 512 + hh * 64 + c8; const bf16_t* vp = a.Vp + (tok0 + m) * 512 + hh * 64 + c8;
    u32x4 qr = *(const u32x4*)qp, kr = *(const u32x4*)kp, vr = *(const u32x4*)vp;
    for (int j = 0; j < 8; ++j) {
        LAS unsigned char* Qs = lds + (j & 1) * 4 * RT; LAS unsigned char* Ks = Qs + RT; LAS unsigned char* Kd = Qs + 2 * RT; LAS unsigned char* Vs = Qs + 3 * RT;
        LAS unsigned char* Stc = Stb + (j & 1) * RT; LAS unsigned char* Stn = Stb + ((j + 1) & 1) * RT;
        *(LAS u32x4*)(Qs + (m * RLD + c8) * 2) = qr; *(LAS u32x4*)(Ks + (m * RLD + c8) * 2) = kr;
        *(LAS u32x4*)(Kd + (m * RLD + c8) * 2) = scale_bf16x8(kr, kdec); *(LAS u32x4*)(Vs + (m * RLD + c8) * 2) = vr;
        __syncthreads();
        if (j + 1 < 8) { qr = *(const u32x4*)(qp + (size_t)(j + 1) * 64 * 512); kr = *(const u32x4*)(kp + (size_t)(j + 1) * 64 * 512); vr = *(const u32x4*)(vp + (size_t)(j + 1) * 64 * 512); }
        {
            const int mi = wid >> 1, ci0 = 2 * (wid & 1);
            f32x4 xs[2] = {(f32x4){0.f, 0.f, 0.f, 0.f}, (f32x4){0.f, 0.f, 0.f, 0.f}};
#pragma unroll
            for (int ks = 0; ks < 2; ++ks) {
                const bf16x8 af = lds_row8(Ks, 16 * mi + l15, 32 * ks + 8 * g);
#pragma unroll
                for (int c = 0; c < 2; ++c) { const bf16x8 bfv = lds_row8(Qs, 16 * (ci0 + c) + l15, 32 * ks + 8 * g); xs[c] = __builtin_amdgcn_mfma_f32_16x16x32_bf16(af, bfv, xs[c], 0, 0, 0); }
            }
#pragma unroll
            for (int c = 0; c < 2; ++c) {
                const int cc = 16 * (ci0 + c) + l15, mm = 16 * mi + 4 * g;
                float pv[4];
#pragma unroll
                for (int r = 0; r < 4; ++r) { const int d = cc - (mm + r); pv[r] = xs[c][r] * __builtin_amdgcn_exp2f(l2g * (float)(d < 0 ? -d : d)); }
                u32x2 w; w.x = cvt_pk_bf16(pv[0], pv[1]); w.y = cvt_pk_bf16(pv[2], pv[3]);
                *(LAS u32x2*)(Ps + (cc * RLD + mm) * 2) = w;
            }
        }
        __syncthreads();
        if (wid < 4) {
            const int cc = 16 * wid + l15; const size_t tok = tok0 + (size_t)j * 64 + cc;
            u32x2 gw[4];
#pragma unroll
            for (int e = 0; e < 4; ++e) gw[e] = *(const u32x2*)(a.Gp + tok * 512 + hh * 64 + 16 * e + 4 * g);
            f32x4 yi[4], ys[4];
#pragma unroll
            for (int e = 0; e < 4; ++e) { yi[e] = (f32x4){0.f, 0.f, 0.f, 0.f}; ys[e] = (f32x4){0.f, 0.f, 0.f, 0.f}; }
#pragma unroll
            for (int ks = 0; ks < 2; ++ks) {
                const bf16x8 pb = lds_row8(Ps, cc, 32 * ks + 8 * g), qb = lds_row8(Qs, cc, 32 * ks + 8 * g);
#pragma unroll
                for (int e = 0; e < 4; ++e) {
                    const bf16x8 va = lds_tr8(Vs, 32 * ks, e, lane);
                    yi[e] = __builtin_amdgcn_mfma_f32_16x16x32_bf16(va, pb, yi[e], 0, 0, 0);
                    const bf16x8 sa = lds_row8(Stc, 16 * e + l15, 32 * ks + 8 * g);
                    ys[e] = __builtin_amdgcn_mfma_f32_16x16x32_bf16(sa, qb, ys[e], 0, 0, 0);
                }
            }
            const float qdec = __builtin_amdgcn_exp2f(l2g * (float)(cc + 1));
            float sum = 0.f;
#pragma unroll
            for (int e = 0; e < 4; ++e) { yi[e] += ys[e] * qdec; sum += (yi[e][0] + yi[e][1]) + (yi[e][2] + yi[e][3]); }
            sum += __shfl_xor(sum, 16); sum += __shfl_xor(sum, 32);
            const float mu = sum * (1.f / 64.f); float vq = 0.f;
#pragma unroll
            for (int e = 0; e < 4; ++e) { const f32x4 d = yi[e] - mu; vq += (d[0] * d[0] + d[1] * d[1]) + (d[2] * d[2] + d[3] * d[3]); }
            vq += __shfl_xor(vq, 16); vq += __shfl_xor(vq, 32);
            const float rs = __builtin_amdgcn_rsqf(vq * (1.f / 64.f) + 1e-5f);
#pragma unroll
            for (int e = 0; e < 4; ++e) {
                const float g0 = bf_lo(gw[e].x), g1 = bf_hi(gw[e].x), g2 = bf_lo(gw[e].y), g3 = bf_hi(gw[e].y);
                u32x2 w; w.x = cvt_pk_bf16((yi[e][0] - mu) * rs * g0 * bt[4 * e], (yi[e][1] - mu) * rs * g1 * bt[4 * e + 1]);
                w.y = cvt_pk_bf16((yi[e][2] - mu) * rs * g2 * bt[4 * e + 2], (yi[e][3] - mu) * rs * g3 * bt[4 * e + 3]);
                *(u32x2*)(a.Y + tok * DM + hh * 64 + 16 * e + 4 * g) = w;
            }
        } else {
            const int di = wid - 4;
#pragma unroll
            for (int e = 0; e < 4; ++e) st[e] *= cdec;
#pragma unroll
            for (int ks = 0; ks < 2; ++ks) {
                const bf16x8 af = lds_tr8(Kd, 32 * ks, di, lane);
#pragma unroll
                for (int e = 0; e < 4; ++e) { const bf16x8 bfv = lds_tr8(Vs, 32 * ks, e, lane); st[e] = __builtin_amdgcn_mfma_f32_16x16x32_bf16(af, bfv, st[e], 0, 0, 0); }
            }
#pragma unroll
            for (int e = 0; e < 4; ++e) { u32x2 w; w.x = cvt_pk_bf16(st[e][0], st[e][1]); w.y = cvt_pk_bf16(st[e][2], st[e][3]); *(LAS u32x2*)(Stn + ((16 * e + l15) * RLD + 16 * di + 4 * g) * 2) = w; }
        }
    }
}

__device__ __forceinline__ void phase_norm2_router(const Args& a, LAS unsigned char* lds) {
    const int tid = threadIdx.x, lane = tid & 63, wid = __builtin_amdgcn_readfirstlane(tid >> 6), g = lane >> 4, l15 = lane & 15, b = blockIdx.x >> 5;
    constexpr int ALD = 1032;
    LAS unsigned char* At = lds;
    LAS float* part = (LAS float*)(lds + 66048);
    LAS float* logit = (LAS float*)(lds + 115200);
    LAS int* hist = (LAS int*)(lds + 121344);
    LAS int* hbase = (LAS int*)(lds + 121344 + 128);
    LAS int* selE = (LAS int*)(lds + 121344 + 256);
    LAS int* selS = (LAS int*)(lds + 121344 + 256 + 512);
    if (tid < 32) hist[tid] = 0;
    float Am[16], Bm[16];
    load_mod_consts(a.g_ffn, a.mod + (size_t)b * MODW, 3 * DM, 4 * DM, lane, Am, Bm);
    bf16x8 Bf[3][4];
#pragma unroll
    for (int nt = 0; nt < 3; ++nt)
#pragma unroll
        for (int ks = 0; ks < 4; ++ks) Bf[nt][ks] = *(const bf16x8*)(a.WrT + (size_t)(16 * nt + l15) * DM + 128 * wid + 32 * ks + 8 * g);
    const int row_base = blockIdx.x * 64;
    for (int it = 0; it < 2; ++it) {
#pragma unroll 1
        for (int q = 0; q < 4; ++q) {
            const int lr = 4 * wid + q, row = row_base + 32 * it + lr;
            const bf16_t* xr = a.x1b + (size_t)row * DM + 4 * lane;
            f32x4 v[4]; float ss = 0.f;
#pragma unroll
            for (int i = 0; i < 4; ++i) { const u32x2 xw = *(const u32x2*)(xr + 256 * i); v[i] = (f32x4){bf_lo(xw.x), bf_hi(xw.x), bf_lo(xw.y), bf_hi(xw.y)}; ss += v[i][0] * v[i][0] + v[i][1] * v[i][1] + v[i][2] * v[i][2] + v[i][3] * v[i][3]; }
            ss = wave_sum(ss);
            const float rs = __builtin_amdgcn_rsqf(ss * (1.f / DM) + 1e-6f);
            unsigned char* hr = a.h2q + (size_t)row * DM + 4 * lane;
#pragma unroll
            for (int i = 0; i < 4; ++i) {
                const float h0 = v[i][0] * rs * Am[4 * i] + Bm[4 * i], h1 = v[i][1] * rs * Am[4 * i + 1] + Bm[4 * i + 1], h2v = v[i][2] * rs * Am[4 * i + 2] + Bm[4 * i + 2], h3 = v[i][3] * rs * Am[4 * i + 3] + Bm[4 * i + 3];
                u32x2 w; w.x = cvt_pk_bf16(h0, h1); w.y = cvt_pk_bf16(h2v, h3);
                *(LAS u32x2*)(At + (lr * ALD + 256 * i + 4 * lane) * 2) = w;
                int pk = __builtin_amdgcn_cvt_pk_fp8_f32(h0, h1, 0, false); pk = __builtin_amdgcn_cvt_pk_fp8_f32(h2v, h3, pk, true);
                *(int*)(hr + 256 * i) = pk;
            }
        }
        __syncthreads();
        {
            f32x4 pa[2][3];
#pragma unroll
            for (int mt = 0; mt < 2; ++mt)
#pragma unroll
                for (int nt = 0; nt < 3; ++nt) pa[mt][nt] = (f32x4){0.f, 0.f, 0.f, 0.f};
#pragma unroll
            for (int ks = 0; ks < 4; ++ks)
#pragma unroll
                for (int mt = 0; mt < 2; ++mt) {
                    const bf16x8 af = *(const LAS bf16x8*)(At + ((16 * mt + l15) * ALD + 128 * wid + 32 * ks + 8 * g) * 2);
#pragma unroll
                    for (int nt = 0; nt < 3; ++nt) pa[mt][nt] = __builtin_amdgcn_mfma_f32_16x16x32_bf16(af, Bf[nt][ks], pa[mt][nt], 0, 0, 0);
                }
#pragma unroll
            for (int mt = 0; mt < 2; ++mt)
#pragma unroll
                for (int nt = 0; nt < 3; ++nt)
#pragma unroll
                    for (int r = 0; r < 4; ++r) part[(wid * 32 + 16 * mt + 4 * g + r) * 48 + 16 * nt + l15] = pa[mt][nt][r];
        }
        __syncthreads();
        for (int idx = tid; idx < 32 * 48; idx += NTHR) {
            const int col = idx % 48; float s = 0.f;
#pragma unroll
            for (int w = 0; w < 8; ++w) s += part[w * 1536 + idx];
            if (col < 4) s += a.rgb[col]; else if (col < 36) s += a.reb[col - 4];
            logit[idx] = s;
        }
        __syncthreads();
        if (tid < 32) {
            const LAS float* lg = logit + tid * 48;
            int gi = 0; float gm = lg[0];
#pragma unroll
            for (int j = 1; j < 4; ++j) { const float v = lg[j]; if (v > gm) { gm = v; gi = j; } }
            float gs = 0.f;
#pragma unroll
            for (int j = 0; j < 4; ++j) gs += __expf(lg[j] - gm);
            const float gtop = 1.f / gs;
            const LAS float* el = lg + 4 + gi * 8;
            int i1 = 0; float l1 = el[0];
#pragma unroll
            for (int j = 1; j < 8; ++j) { const float v = el[j]; if (v > l1) { l1 = v; i1 = j; } }
            int i2 = 0; float l2 = -3.0e38f;
#pragma unroll
            for (int j = 0; j < 8; ++j) { const float v = el[j]; if (j != i1 && v > l2) { l2 = v; i2 = j; } }
            const float ex = __expf(l2 - l1);
            const float w1 = gtop / (1.f + ex), w2 = gtop * ex / (1.f + ex);
            const int e0 = gi * 8 + i1, e1 = gi * 8 + i2, tl = 32 * it + tid, t = row_base + tl;
            selE[2 * tl] = e0; selS[2 * tl] = atomicAdd((int*)&hist[e0], 1);
            selE[2 * tl + 1] = e1; selS[2 * tl + 1] = atomicAdd((int*)&hist[e1], 1);
            a.pw[2 * t] = w1; a.pw[2 * t + 1] = w2;
        }
    }
    __syncthreads();
    if (tid < 32) { const int n = hist[tid]; hbase[tid] = n ? atomicAdd(&a.counts[tid], n) : 0; }
    __syncthreads();
    if (tid < 128) { const int e = selE[tid]; a.lists[e * LCAP + hbase[e] + selS[tid]] = 2 * row_base + tid; }
}

__device__ __forceinline__ void phase_final(const Args& a, float* dst) {
    const int tid = threadIdx.x, lane = tid & 63, wid = tid >> 6, b = blockIdx.x >> 5;
    float gf[16], gn[16];
#pragma unroll
    for (int i = 0; i < 4; ++i) {
        const f32x4 g1 = *(const f32x4*)(a.mod + (size_t)b * MODW + 5 * DM + 256 * i + 4 * lane), g2 = *(const f32x4*)(a.g_fin + 256 * i + 4 * lane);
#pragma unroll
        for (int j = 0; j < 4; ++j) { gf[4 * i + j] = g1[j] * 0.0625f; gn[4 * i + j] = g2[j]; }
    }
#pragma unroll 2
    for (int q = 0; q < 8; ++q) {
        const int row = blockIdx.x * 64 + wid * 8 + q;
        const bf16_t* xr = a.x1b + (size_t)row * DM + 4 * lane;
        const unsigned char* o0 = (const unsigned char*)a.opair + (size_t)(2 * row) * DM + 4 * lane; const unsigned char* o1 = o0 + DM;
        f32x4 v[4]; float ss = 0.f;
#pragma unroll
        for (int i = 0; i < 4; ++i) {
            const u32x2 xw = *(const u32x2*)(xr + 256 * i); const f32x4 xv = (f32x4){bf_lo(xw.x), bf_hi(xw.x), bf_lo(xw.y), bf_hi(xw.y)}; const int pa = *(const int*)(o0 + 256 * i), pb = *(const int*)(o1 + 256 * i);
            v[i][0] = xv[0] + gf[4 * i] * (__builtin_amdgcn_cvt_f32_fp8(pa, 0) + __builtin_amdgcn_cvt_f32_fp8(pb, 0)); v[i][1] = xv[1] + gf[4 * i + 1] * (__builtin_amdgcn_cvt_f32_fp8(pa, 1) + __builtin_amdgcn_cvt_f32_fp8(pb, 1));
            v[i][2] = xv[2] + gf[4 * i + 2] * (__builtin_amdgcn_cvt_f32_fp8(pa, 2) + __builtin_amdgcn_cvt_f32_fp8(pb, 2)); v[i][3] = xv[3] + gf[4 * i + 3] * (__builtin_amdgcn_cvt_f32_fp8(pa, 3) + __builtin_amdgcn_cvt_f32_fp8(pb, 3));
            ss += v[i][0] * v[i][0] + v[i][1] * v[i][1] + v[i][2] * v[i][2] + v[i][3] * v[i][3];
        }
        ss = wave_sum(ss);
        const float rs = __builtin_amdgcn_rsqf(ss * (1.f / DM) + 1e-6f);
#pragma unroll
        for (int i = 0; i < 4; ++i) {
            f32x4 o; o[0] = v[i][0] * rs * gn[4 * i]; o[1] = v[i][1] * rs * gn[4 * i + 1]; o[2] = v[i][2] * rs * gn[4 * i + 2]; o[3] = v[i][3] * rs * gn[4 * i + 3];
            *(f32x4*)(dst + (size_t)row * DM + 4 * lane + 256 * i) = o;
        }
    }
}

#ifndef PROBE_DUP
#define PROBE_DUP 0
#endif
#define RUN(p) (a.p0 <= (p) && (p) < a.p1)
#define REP(p, ...) do { __VA_ARGS__ if constexpr (((PROBE_DUP) >> (p)) & 1) { __VA_ARGS__ } } while (0)
#define SYNC(p) do { if (a.p0 <= (p) && (p) + 1 < a.p1) { xcd_barrier(bar); if constexpr ((PROBE_DUP >> 16) & 1) xcd_barrier(bar); } } while (0)
__global__ void __launch_bounds__(NTHR, 2) mk_fwd(Args a) {
    extern __shared__ __attribute__((aligned(16))) unsigned char shm[];
    LAS unsigned char* lds = (LAS unsigned char*)shm;
    volatile LAS unsigned* xbw = (volatile LAS unsigned*)(lds + LDS_MISC);
    if (threadIdx.x < 4) xbw[threadIdx.x] = 0u;
    __syncthreads();
    XcdBarrier bar; bar.bar = a.bar; bar.x = 0; bar.st = xbw;
    if (a.p1 - a.p0 > 1) bar = xcd_barrier_post(a.bar, xbw);
    LAS int* mpre = (LAS int*)(lds + LDS_MISC + 64); LAS int* mcnt = (LAS int*)(lds + LDS_MISC + 64 + 256);

    if (RUN(0)) REP(0, { phase_prep(a, lds); __syncthreads(); });
    SYNC(0);
    if (RUN(1)) REP(1, phase_norm1(a););
    SYNC(1);
    if (RUN(2)) REP(2, { if (blockIdx.x >= NGEMM) { convert_tiles<1>(a, (LAS float*)(lds + (threadIdx.x >> 6) * 16640), W1_PRE + (blockIdx.x - NGEMM) * 8 + (threadIdx.x >> 6), 8192, (NWG - NGEMM) * 8, threadIdx.x & 63); } else {
        ProbInProj P; P.K = DM; P.S.init(NTOK, INC, NGEMM, blockIdx.x); P.A = (const char*)a.h; P.Bt = (const char*)a.WinT; P.pos = a.pos;
        P.Qp = a.Qp; P.Kp = a.Kp; P.Vp = a.Vp; P.Gp = a.Gp; P.Bp = a.Bp; P.Up = a.Up; pg8::gemm_phase(lds, P); } });
    SYNC(2);
    if (RUN(3)) REP(3, { phase_conv_seg(a, lds); __syncthreads(); });
    __syncthreads();
    if (RUN(4)) REP(4, { phase_ret_out(a, lds); __syncthreads(); });
    SYNC(4);
    if (RUN(5)) REP(5, { ProbOutProj P; P.K = DM; P.S.init(NTOK, DM, gridDim.x, blockIdx.x); P.A = (const char*)a.Y; P.Bt = (const char*)a.WoutT; P.x = a.x; P.mod = a.mod; P.x1 = a.x1b; pg8::gemm_phase(lds, P); });
    SYNC(5);
    if constexpr ((PROBE_DUP >> 6) & 1) { Args a2 = a; a2.counts = a.counts + 32; phase_norm2_router(a2, lds); __syncthreads(); }
    if (RUN(6)) phase_norm2_router(a, lds);
    SYNC(6);
    if (RUN(7)) REP(7, { if (blockIdx.x >= NGEMM) { convert_tiles<2>(a, (LAS float*)(lds + (threadIdx.x >> 6) * 16640), W2_PRE + (blockIdx.x - NGEMM) * 8 + (threadIdx.x >> 6), 4096, (NWG - NGEMM) * 8, threadIdx.x & 63); } else {
        __syncthreads(); moe_tables(a.counts, mpre, mcnt);
        ProbMoe1 P; P.K = DM / 2; P.S.pre = mpre; P.S.cnts = mcnt; P.S.G = NGEMM; P.S.c = blockIdx.x; P.S.NT = 4; P.A = (const char*)a.h2q; P.Bt = (const char*)a.W1Q; P.lists = a.lists; P.pw = a.pw; P.hid = a.hid; pg8::gemm_phase_f8(lds, P); } });
    SYNC(7);
    if (RUN(8)) REP(8, { __syncthreads(); moe_tables(a.counts, mpre, mcnt);
        ProbMoe2 P; P.K = DE / 2; P.S.pre = mpre; P.S.cnts = mcnt; P.S.G = gridDim.x; P.S.c = blockIdx.x; P.S.NT = 4; P.A = (const char*)a.hidq; P.Bt = (const char*)a.W2Q; P.lists = a.lists; P.opair = a.opair; pg8::gemm_phase_f8(lds, P); });
    SYNC(8);
    if constexpr ((PROBE_DUP >> 9) & 1) { phase_final(a, (float*)a.W1T); }
    if (RUN(9)) phase_final(a, a.out);
}

extern "C" void kernel_launch(void* const* d_in, const int* in_sizes, int n_in, void* d_out, int out_size, void* d_ws, size_t ws_size, hipStream_t stream) {
    Args a; memset(&a, 0, sizeof(a));
    a.x = (const float*)d_in[0]; a.c = (const float*)d_in[1]; a.pos = (const int*)d_in[2]; a.ada_w = (const float*)d_in[3]; a.ada_b = (const float*)d_in[4];
    a.g_mix = (const float*)d_in[5]; a.g_ffn = (const float*)d_in[6]; a.w_in = (const float*)d_in[7]; a.conv_w = (const float*)d_in[8]; a.conv_b = (const float*)d_in[9];
    a.beta_ret = (const float*)d_in[10]; a.beta_conv = (const float*)d_in[11]; a.w_out = (const float*)d_in[12]; a.rgw = (const float*)d_in[13]; a.rgb = (const float*)d_in[14];
    a.rew = (const float*)d_in[15]; a.reb = (const float*)d_in[16]; a.ewg = (const float*)d_in[17]; a.ewu = (const float*)d_in[18]; a.ewd = (const float*)d_in[19]; a.g_fin = (const float*)d_in[20];
    a.out = (float*)d_out;
    char* ws = (char*)d_ws; size_t off = 0;
    auto carve = [&](size_t bytes) { void* p = ws + off; off += (bytes + 255) & ~(size_t)255; return p; };
    a.bar = (unsigned*)carve(XCD_BAR_WORDS * 4);
    a.counts = (int*)carve(256);
    a.segflag = (unsigned*)carve(256 * 64);
    const size_t zero_bytes = off;
    a.mod = (float*)carve((size_t)NB * MODW * 4);
    a.lists = (int*)carve((size_t)NE * LCAP * 4);
    a.pw = (float*)carve((size_t)2 * NTOK * 4);
    a.sseg = (float*)carve((size_t)256 * 4096 * 4);
    a.WrT = (bf16_t*)carve((size_t)48 * DM * 2);
    a.WinT = (bf16_t*)carve((size_t)INC * DM * 2);
    a.WoutT = (bf16_t*)carve((size_t)DM * DM * 2);
    a.W1T = (bf16_t*)carve((size_t)NE * 1024 * DM * 2);
    a.W2T = (bf16_t*)carve((size_t)NE * 1024 * DE * 2);
    a.h = (bf16_t*)carve((size_t)NTOK * DM * 2);
    bf16_t* big = (bf16_t*)carve((size_t)NTOK * 512 * 2 * 6);
    a.Y = (bf16_t*)carve((size_t)NTOK * DM * 2);
    if (off > ws_size) return;
    a.Qp = big; a.Kp = big + (size_t)NTOK * 512; a.Vp = big + (size_t)NTOK * 512 * 2; a.Gp = big + (size_t)NTOK * 512 * 3; a.Bp = big + (size_t)NTOK * 512 * 4; a.Up = big + (size_t)NTOK * 512 * 5;
    a.h2 = a.h; a.hid = a.Y; a.opair = big; a.h2q = (unsigned char*)a.h; a.hidq = (unsigned char*)a.Y; a.W1Q = (unsigned char*)a.W1T; a.W2Q = (unsigned char*)a.W2T; a.x1b = big + (size_t)NTOK * 512 * 4;

    static bool attr = false;
    if (!attr) { (void)hipFuncSetAttribute((const void*)mk_fwd, hipFuncAttributeMaxDynamicSharedMemorySize, LDS_BYTES); attr = true; }
    (void)hipMemsetAsync(d_ws, 0, zero_bytes, stream);
#if MK_LAUNCHES == 1
    a.p0 = 0; a.p1 = 10;
    hipLaunchKernelGGL(mk_fwd, dim3(NWG), dim3(NTHR), LDS_BYTES, stream, a);
#else
    for (int p = 0; p < 10; ++p) { a.p0 = p; a.p1 = p + 1; hipLaunchKernelGGL(mk_fwd, dim3(NWG), dim3(NTHR), LDS_BYTES, stream, a); }
#endif
}
```
